# Optimizing an MI355X kernel written in HIP

```python
import math
import jax, jax.numpy as jnp
from jax import lax
import numpy as np

D_MODEL = 2048
BATCH = 1
SEQ = 8192
DEPTH = 1

GRID_W = 64
CTX_LEN = 256
D_MIX = D_MODEL
DIFF_HEADS = 8
DIFF_HEAD_DIM = 64
DIFF_V_DIM = 2 * DIFF_HEAD_DIM
ATT_W = DIFF_HEADS * DIFF_V_DIM
CONV_W = D_MIX - ATT_W
CONV_K = 31
Q_BLOCK = 128
ROPE_BASE = 10000.0
EPS = 1e-6

Q0 = 0
K0 = Q0 + DIFF_HEADS * 2 * DIFF_HEAD_DIM
V0 = K0 + DIFF_HEADS * 2 * DIFF_HEAD_DIM
GA0 = V0 + ATT_W
U0 = GA0 + ATT_W
GC0 = U0 + 2 * CONV_W
IN_W = GC0 + CONV_W

kernel_name = "hybrid_diffattn_conformer_dit_layer"


def rms(x, g):
    xf = x.astype(jnp.float32)
    y = xf * lax.rsqrt(jnp.mean(xf * xf, axis=-1, keepdims=True) + EPS)
    return (y * g).astype(x.dtype)


def layernorm(x, g, b):
    xf = x.astype(jnp.float32)
    mu = jnp.mean(xf, axis=-1, keepdims=True)
    var = jnp.mean(jnp.square(xf - mu), axis=-1, keepdims=True)
    return ((xf - mu) * lax.rsqrt(var + EPS) * g + b).astype(x.dtype)


def adaln(cvec, w, b):
    m = jax.nn.silu(cvec) @ w + b
    return jnp.split(m, 3, axis=-1)


def modulate(x, g, shift, scale):
    return rms(x, g) * (1.0 + scale[:, None]) + shift[:, None]


def rope_tables(n_tokens):
    rows = n_tokens // GRID_W
    row = jnp.repeat(jnp.arange(rows), GRID_W).astype(jnp.float32)
    col = jnp.tile(jnp.arange(GRID_W), rows).astype(jnp.float32)
    nf = DIFF_HEAD_DIM // 4
    inv = ROPE_BASE ** (-jnp.arange(nf, dtype=jnp.float32) / nf)
    ang_r = row[:, None] * inv
    ang_c = col[:, None] * inv
    ang = jnp.concatenate([ang_r, ang_r, ang_c, ang_c], axis=-1)
    return jnp.cos(ang), jnp.sin(ang)


def rotate_half_2d(t):
    nf = DIFF_HEAD_DIM // 4
    xs = t.reshape(t.shape[:-1] + (2, 2, nf))
    x1 = xs[..., 0, :]
    x2 = xs[..., 1, :]
    return jnp.stack([-x2, x1], axis=-2).reshape(t.shape)


def apply_rope(t, cos, sin):
    c = cos[None, :, None, None, :]
    s = sin[None, :, None, None, :]
    return (t * c + rotate_half_2d(t) * s).astype(t.dtype)


def diff_attend(q, k_all, v_all, lam):
    B, N, H, _, d = q.shape
    nblk = N // Q_BLOCK
    qb = jnp.moveaxis(q.reshape(B, nblk, Q_BLOCK, H, 2, d), 1, 0)
    scale = 1.0 / math.sqrt(d)

    def one_block(qi):
        s = jnp.einsum('bqhmd,bkhmd->bhmqk', qi, k_all).astype(jnp.float32) * scale
        p = jax.nn.softmax(s, axis=-1)
        a = p[:, :, 0] - lam * p[:, :, 1]
        return jnp.einsum('bhqk,bkhe->bqhe', a.astype(v_all.dtype), v_all)

    o = lax.map(one_block, qb)
    return jnp.moveaxis(o, 0, 1).reshape(B, N, H, DIFF_V_DIM)


def diff_attn_branch(q, k_all, v_all, lam, lam_init, sub_g):
    B, N = q.shape[0], q.shape[1]
    o = diff_attend(q, k_all, v_all, lam)
    o = rms(o, sub_g) * (1.0 - lam_init)
    return o.reshape(B, N, ATT_W)


def depthwise_conv(y, w, b):
    out = lax.conv_general_dilated(
        y, w[:, None, :].astype(y.dtype), window_strides=(1,),
        padding=[(CONV_K // 2, CONV_K // 2)],
        dimension_numbers=('NWC', 'WIO', 'NWC'),
        feature_group_count=y.shape[-1])
    return out + b


def conformer_conv_branch(u, w, b, ln_g, ln_b):
    a, g = jnp.split(u, 2, axis=-1)
    y = a * jax.nn.sigmoid(g)
    y = depthwise_conv(y, w, b)
    y = layernorm(y, ln_g, ln_b)
    return jax.nn.silu(y)


def setup_inputs(seed: int = 0) -> dict:
    key = jax.random.key(seed)
    ks = jax.random.split(key, 24)
    f32 = jnp.float32
    nrm = lambda k, s, sc: (jax.random.normal(k, s, f32) * sc)
    d = DIFF_HEAD_DIM
    return {
        "x": nrm(ks[0], (BATCH, SEQ, D_MODEL), 1.0),
        "c": nrm(ks[1], (BATCH, D_MODEL), 1.0),
        "ctx": nrm(ks[2], (BATCH, CTX_LEN, D_MODEL), 1.0),
        "c_ctx": nrm(ks[3], (D_MODEL,), 1.0),
        "w_ada": nrm(ks[4], (DEPTH, D_MODEL, 3 * D_MODEL), 0.5 * D_MODEL ** -0.5),
        "b_ada": nrm(ks[5], (DEPTH, 3 * D_MODEL), 0.02),
        "norm_g": 1.0 + nrm(ks[6], (DEPTH, D_MODEL), 0.02),
        "w_in": nrm(ks[7], (DEPTH, D_MODEL, IN_W), D_MODEL ** -0.5),
        "q_norm_g": 1.0 + nrm(ks[8], (DEPTH, d), 0.02),
        "k_norm_g": 1.0 + nrm(ks[9], (DEPTH, d), 0.02),
        "lam_q1": nrm(ks[10], (DEPTH, d), 0.1),
        "lam_k1": nrm(ks[11], (DEPTH, d), 0.1),
        "lam_q2": nrm(ks[12], (DEPTH, d), 0.1),
        "lam_k2": nrm(ks[13], (DEPTH, d), 0.1),
        "sub_norm_g": 1.0 + nrm(ks[14], (DEPTH, DIFF_V_DIM), 0.02),
        "conv_w": nrm(ks[15], (DEPTH, CONV_K, CONV_W), CONV_K ** -0.5),
        "conv_b": nrm(ks[16], (DEPTH, CONV_W), 0.02),
        "conv_ln_g": 1.0 + nrm(ks[17], (DEPTH, CONV_W), 0.02),
        "conv_ln_b": nrm(ks[18], (DEPTH, CONV_W), 0.02),
        "w_out": nrm(ks[19], (DEPTH, D_MIX, D_MODEL), D_MIX ** -0.5),
    }


def reference(x, c, ctx, c_ctx, w_ada, b_ada, norm_g, w_in, q_norm_g, k_norm_g,
              lam_q1, lam_k1, lam_q2, lam_k2, sub_norm_g, conv_w, conv_b,
              conv_ln_g, conv_ln_b, w_out):
    B, N, _ = x.shape
    L_ctx = ctx.shape[1]
    H, d = DIFF_HEADS, DIFF_HEAD_DIM
    cos, sin = rope_tables(N)
    for i in range(DEPTH):
        last = i == DEPTH - 1
        lam_init = 0.8 - 0.6 * math.exp(-0.3 * i)
        lam = (jnp.exp(jnp.sum(lam_q1[i] * lam_k1[i]).astype(jnp.float32))
               - jnp.exp(jnp.sum(lam_q2[i] * lam_k2[i]).astype(jnp.float32)) + lam_init)

        shift_x, scale_x, gate_x = adaln(c, w_ada[i], b_ada[i])
        shift_c, scale_c, gate_c = adaln(c_ctx[None], w_ada[i], b_ada[i])
        h_x = modulate(x, norm_g[i], shift_x, scale_x)
        h_c = modulate(ctx, norm_g[i], shift_c, scale_c)

        p_x = h_x @ w_in[i]
        if last:
            p_c_kv = h_c @ w_in[i][:, K0:GA0]
        else:
            p_c = h_c @ w_in[i]
            p_c_kv = p_c[..., K0:GA0]

        k_c = rms(p_c_kv[..., :V0 - K0].reshape(B, L_ctx, H, 2, d), k_norm_g[i])
        v_c = p_c_kv[..., V0 - K0:].reshape(B, L_ctx, H, DIFF_V_DIM)

        q_x = apply_rope(rms(p_x[..., Q0:K0].reshape(B, N, H, 2, d), q_norm_g[i]), cos, sin)
        k_x = apply_rope(rms(p_x[..., K0:V0].reshape(B, N, H, 2, d), k_norm_g[i]), cos, sin)
        v_x = p_x[..., V0:GA0].reshape(B, N, H, DIFF_V_DIM)
        k_all = jnp.concatenate([k_c, k_x], axis=1)
        v_all = jnp.concatenate([v_c, v_x], axis=1)

        att_x = diff_attn_branch(q_x, k_all, v_all, lam, lam_init, sub_norm_g[i])
        conv_x = conformer_conv_branch(p_x[..., U0:GC0], conv_w[i], conv_b[i],
                                       conv_ln_g[i], conv_ln_b[i])
        mixed_x = jnp.concatenate([att_x * jax.nn.silu(p_x[..., GA0:U0]),
                                   conv_x * jax.nn.silu(p_x[..., GC0:IN_W])], axis=-1)
        y_x = mixed_x @ w_out[i]

        if not last:
            q_c = rms(p_c[..., Q0:K0].reshape(B, L_ctx, H, 2, d), q_norm_g[i])
            att_c = diff_attn_branch(q_c, k_c, v_c, lam, lam_init, sub_norm_g[i])
            conv_c = conformer_conv_branch(p_c[..., U0:GC0], conv_w[i], conv_b[i],
                                           conv_ln_g[i], conv_ln_b[i])
            mixed_c = jnp.concatenate([att_c * jax.nn.silu(p_c[..., GA0:U0]),
                                       conv_c * jax.nn.silu(p_c[..., GC0:IN_W])], axis=-1)
            ctx = ctx + gate_c[:, None] * (mixed_c @ w_out[i])

        x = x + gate_x[:, None] * y_x
    return x
```

```cpp
#include <hip/hip_runtime.h>
#include <hip/hip_cooperative_groups.h>
#include <cstdio>
#include <cstdint>
namespace cg = cooperative_groups;

#ifndef MK_N_LAUNCHES
#define MK_N_LAUNCHES 1
#endif

#define LAS __attribute__((address_space(3)))
typedef unsigned short bf16_t;
typedef short bf16x8 __attribute__((ext_vector_type(8)));
typedef float f32x2 __attribute__((ext_vector_type(2)));
typedef float f32x4 __attribute__((ext_vector_type(4)));
typedef float f32x16 __attribute__((ext_vector_type(16)));
typedef unsigned u32x2 __attribute__((ext_vector_type(2)));
typedef unsigned u32x4 __attribute__((ext_vector_type(4)));
typedef __bf16 bf16x2_t __attribute__((ext_vector_type(2)));

constexpr int DM = 2048, SEQ = 8192, CTXL = 256, NTOK = SEQ + CTXL, INW = 7168;
constexpr int NH = 8, HD = 64, VD = 128, ATTW = 1024, CONVW = 1024, CONVK = 31;
constexpr float EPS = 1e-6f;
constexpr float LOG2E = 1.4426950408889634f;
constexpr float QSCALE = 0.125f * LOG2E;
constexpr float LAM_INIT = 0.2f;

constexpr size_t MiB = 1u << 20;
constexpr size_t WS_MOD = 0;
constexpr size_t WS_BAR = 49152;
constexpr size_t WS_P0CNT = 63488;
constexpr size_t WS_ZERO_BYTES = 65536;
constexpr size_t WS_TAB = 65536;
constexpr size_t WS_WT = 1 * MiB;
constexpr size_t WS_WO = 29 * MiB;
constexpr size_t WS_H = 40 * MiB;
constexpr size_t WS_Q = 74 * MiB;
constexpr size_t WS_K = 90 * MiB;
constexpr size_t WS_VT = 107 * MiB;
constexpr size_t WS_GA = 124 * MiB;
constexpr size_t WS_Y = 140 * MiB;
constexpr size_t WS_GC = 156 * MiB;
constexpr size_t WS_MIX = 172 * MiB;
constexpr size_t WS_END = 204 * MiB;

constexpr int LDS_BYTES = 147456;

__device__ __forceinline__ unsigned cvtpk(float lo, float hi) { f32x2 v = {lo, hi}; bf16x2_t b = __builtin_convertvector(v, bf16x2_t); return __builtin_bit_cast(unsigned, b); }
__device__ __forceinline__ float bf_lo(unsigned u) { return __builtin_bit_cast(float, u << 16); }
__device__ __forceinline__ float bf_hi(unsigned u) { return __builtin_bit_cast(float, u & 0xffff0000u); }
__device__ __forceinline__ float wave_sum(float v) {
#pragma unroll
    for (int o = 1; o < 64; o <<= 1) v += __shfl_xor(v, o);
    return v;
}
__device__ __forceinline__ float wave_max(float v) {
#pragma unroll
    for (int o = 1; o < 64; o <<= 1) v = fmaxf(v, __shfl_xor(v, o));
    return v;
}
__device__ __forceinline__ float silu_f(float v) { return v * __builtin_amdgcn_rcpf(1.0f + __builtin_amdgcn_exp2f(-v * LOG2E)); }
__device__ __forceinline__ float sigmoid_f(float v) { return __builtin_amdgcn_rcpf(1.0f + __builtin_amdgcn_exp2f(-v * LOG2E)); }
__device__ __forceinline__ float fadd_s(float a, float b) { float r; asm("v_add_f32_e32 %0, %1, %2" : "=v"(r) : "v"(a), "v"(b)); return r; }
__device__ __forceinline__ int perm5(int f5) { return 16 * ((f5 >> 2) & 1) + 4 * (f5 >> 3) + (f5 & 3); }

namespace pg8 {
constexpr int BM = 256, BK = 64, HALF = 128, HTB = HALF * BK * 2, STAGE_BYTES = 8 * HTB;
constexpr int GK = 2048;
__device__ __forceinline__ int lds_byte(int r, int c) { const int st = (r >> 4) * 2 + (c >> 5), rr = r & 15, cc = c & 31, ob = rr * 64 + cc * 2; return st * 1024 + (ob ^ (((ob >> 9) & 1) << 5)); }
__device__ __forceinline__ void stage_rc(int b, int& R, int& C) { const int st = b / 1024, sb = b % 1024, swz = sb ^ (((sb >> 9) & 1) << 5); R = (st >> 1) * 16 + swz / 64; C = (st & 1) * 32 + (swz % 64) / 2; }

struct Unit { const char* a; const char* b; int kind, pm, pn; };

template <class Epi, class Sched>
__device__ __forceinline__ void gemm_phase(LAS unsigned char* lds, const Sched& S, const Epi& E) {
    const int tid = threadIdx.x, wid = __builtin_amdgcn_readfirstlane(tid >> 6), lane = tid & 63, wr = wid >> 2, wc = wid & 3, fr = lane & 15, fq = lane >> 4;
    constexpr int K = GK, nt = K / BK;
    unsigned voffA[2];
#pragma unroll
    for (int i = 0; i < 2; ++i) { int R, C; stage_rc(tid * 16 + i * 8192, R, C); voffA[i] = (unsigned)(R * K + C) * 2u; }
    const size_t kstep = (size_t)(BK * 2);
    const size_t hstep = (size_t)HALF * K * 2;
    const unsigned ldsw = (unsigned)wid * 1024u;
    const int aoff = lds_byte(wr * 64 + fr, fq * 8), boff = lds_byte(wc * 32 + fr, fq * 8);
#define PG8_SA(b, h) (((b) * 2 + (h)) * HTB)
#define PG8_SB(b, h) ((4 + (b) * 2 + (h)) * HTB)
#define PG8_STAGE(bufoff, gbase) do { _Pragma("unroll") for (int _i = 0; _i < 2; ++_i) \
        __builtin_amdgcn_global_load_lds((const unsigned*)((const char*)(gbase) + voffA[_i]), (LAS unsigned*)(lds + (bufoff) + ldsw + _i * 8192), 16, 0, 0); } while (0)
#define PG8_LDA(dst, b, h) do { _Pragma("unroll") for (int m = 0; m < 4; ++m) _Pragma("unroll") for (int k = 0; k < 2; ++k) dst[m][k] = *(const LAS bf16x8*)(lds + PG8_SA(b, h) + aoff + m * 2048 + k * 1024); } while (0)
#define PG8_LDB(dst, b, h) do { _Pragma("unroll") for (int n = 0; n < 2; ++n) _Pragma("unroll") for (int k = 0; k < 2; ++k) dst[n][k] = *(const LAS bf16x8*)(lds + PG8_SB(b, h) + boff + n * 2048 + k * 1024); } while (0)
#define PG8_MMA(ai, bj, At, Bt) do { __builtin_amdgcn_s_setprio(1); _Pragma("unroll") for (int m = 0; m < 4; ++m) _Pragma("unroll") for (int n = 0; n < 2; ++n) _Pragma("unroll") for (int k = 0; k < 2; ++k) \
        acc[ai][bj][m][n] = __builtin_amdgcn_mfma_f32_16x16x32_bf16(Bt[n][k], At[m][k], acc[ai][bj][m][n], 0, 0, 0); __builtin_amdgcn_s_setprio(0); } while (0)
#define PG8_WAIT_V(n) asm volatile("s_waitcnt vmcnt(" #n ")" ::: "memory")
#define PG8_WAIT_L(n) asm volatile("s_waitcnt lgkmcnt(" #n ")" ::: "memory")
#define PG8_BAR __builtin_amdgcn_s_barrier()
#define PG8_SCHED __builtin_amdgcn_sched_barrier(0)
    Unit cur, nxt; int ui = 0;
    if (!S.next(0, cur)) return;
    f32x4 acc[2][2][4][2];
#pragma unroll
    for (int a = 0; a < 2; ++a)
#pragma unroll
        for (int b = 0; b < 2; ++b)
#pragma unroll
            for (int m = 0; m < 4; ++m)
#pragma unroll
                for (int n = 0; n < 2; ++n) acc[a][b][m][n] = (f32x4){0.f, 0.f, 0.f, 0.f};
    bf16x8 At[4][2], B0[2][2], B1[2][2];
    const char* cA = cur.a; const char* cB = cur.b;
    PG8_STAGE(PG8_SB(0, 0), cB); PG8_STAGE(PG8_SB(0, 1), cB + hstep); PG8_STAGE(PG8_SA(0, 0), cA); PG8_STAGE(PG8_SA(0, 1), cA + hstep);
    if (wr == 1) PG8_BAR;
    PG8_WAIT_V(2); PG8_BAR;
    PG8_STAGE(PG8_SB(1, 0), cB + kstep); PG8_STAGE(PG8_SA(1, 0), cA + kstep); PG8_STAGE(PG8_SB(1, 1), cB + hstep + kstep);
    PG8_WAIT_V(6); PG8_BAR;
    for (;;) {
        const bool has_next = S.next(ui + 1, nxt);
        const char* nA = has_next ? nxt.a : cA; const char* nB = has_next ? nxt.b : cB;
        for (int t = 0; t < nt; t += 2) {
            const bool last = (t == nt - 2);
            const char* a1 = cA + (size_t)(t + 1) * kstep;
            const char* a2 = last ? nA : cA + (size_t)(t + 2) * kstep; const char* b2 = last ? nB : cB + (size_t)(t + 2) * kstep;
            const char* a3 = a2 + kstep; const char* b3 = b2 + kstep;
            PG8_LDB(B0, 0, 0); PG8_LDB(B1, 0, 1); PG8_SCHED; PG8_LDA(At, 0, 0); PG8_STAGE(PG8_SA(1, 1), a1 + hstep);
            PG8_WAIT_V(8); PG8_WAIT_L(0); PG8_BAR; PG8_MMA(0, 0, At, B0); PG8_MMA(0, 1, At, B1); PG8_BAR; PG8_SCHED;
            PG8_LDA(At, 0, 1); PG8_STAGE(PG8_SB(0, 0), b2); PG8_STAGE(PG8_SB(0, 1), b2 + hstep); PG8_STAGE(PG8_SA(0, 0), a2);
            PG8_WAIT_V(8); PG8_WAIT_L(0); PG8_BAR; PG8_MMA(1, 0, At, B0); PG8_MMA(1, 1, At, B1); PG8_BAR; PG8_SCHED;
            PG8_LDB(B0, 1, 0); PG8_LDB(B1, 1, 1); PG8_SCHED; PG8_LDA(At, 1, 0); PG8_STAGE(PG8_SA(0, 1), a2 + hstep);
            PG8_WAIT_V(8); PG8_WAIT_L(0); PG8_BAR; PG8_MMA(0, 0, At, B0); PG8_MMA(0, 1, At, B1); PG8_BAR; PG8_SCHED;
            PG8_LDA(At, 1, 1); PG8_STAGE(PG8_SB(1, 0), b3); PG8_STAGE(PG8_SB(1, 1), b3 + hstep); PG8_STAGE(PG8_SA(1, 0), a3);
            PG8_WAIT_V(8); PG8_WAIT_L(0); PG8_BAR; PG8_MMA(1, 0, At, B0); PG8_MMA(1, 1, At, B1); PG8_BAR; PG8_SCHED;
        }
        if (wr == 0) PG8_BAR;
        E(acc, cur, wr, wc, fr, fq);
        if (!has_next) break;
#pragma unroll
        for (int a = 0; a < 2; ++a)
#pragma unroll
            for (int b = 0; b < 2; ++b)
#pragma unroll
                for (int m = 0; m < 4; ++m)
#pragma unroll
                    for (int n = 0; n < 2; ++n) acc[a][b][m][n] = (f32x4){0.f, 0.f, 0.f, 0.f};
        cur = nxt; cA = nA; cB = nB; ++ui;
        if (wr == 1) PG8_BAR;
    }
    PG8_WAIT_V(0);
    PG8_BAR;
#undef PG8_SA
#undef PG8_SB
#undef PG8_STAGE
#undef PG8_LDA
#undef PG8_LDB
#undef PG8_MMA
#undef PG8_WAIT_V
#undef PG8_WAIT_L
#undef PG8_BAR
#undef PG8_SCHED
}
}

struct Args { const float* in[20]; float* out; unsigned char* ws; int ph_lo, ph_hi; };
template <int OFF> __device__ __forceinline__ unsigned long long karg64() {
    unsigned long long v;
    asm volatile("s_load_dwordx2 %0, %1, %2\n\ts_waitcnt lgkmcnt(0)" : "=s"(v) : "s"(__builtin_amdgcn_kernarg_segment_ptr()), "n"(OFF) : "memory");
    return v;
}
#define GAS __attribute__((address_space(1)))
#define KIN(i) ((const float*)(GAS const float*)karg64<8 * (i)>())
#define KOUT ((float*)(GAS float*)karg64<160>())
#define KWS ((unsigned char*)(GAS unsigned char*)karg64<168>())
enum { I_X = 0, I_C, I_CTX, I_CCTX, I_WADA, I_BADA, I_NORMG, I_WIN, I_QG, I_KG, I_LQ1, I_LK1, I_LQ2, I_LK2, I_SUBG, I_CONVW, I_CONVB, I_LNG, I_LNB, I_WOUT };

struct SchedIn {
    const char* ws; int c, G, L0, L1;
    __device__ __forceinline__ bool next(int i, pg8::Unit& u) const {
        const int L = L0 + i * G + c; if (L >= L1) return false;
        constexpr size_t RB = (size_t)DM * 2;
        const char* H = ws + WS_H; const char* WT = ws + WS_WT;
        if (L < 768) {
            int wgid = (L % 8) * 96 + L / 8;
            const int gid = wgid / 192, rem = wgid % 192;
            const int pm = gid * 8 + (rem % 8), pn = rem / 8;
            u.a = H + (size_t)(256 + 256 * pm) * RB; u.b = WT + (size_t)(256 * pn) * RB; u.pm = pm; u.pn = pn;
            u.kind = (pn < 8) ? 0 : ((pn >= 12 && pn < 20) ? 2 : 1);
        } else if (L < 900) {
            const int idx = L - 768, pm = idx & 3, pn = idx >> 2;
            u.a = WT + (size_t)(6144 + 256 * pm) * RB; u.b = H + (size_t)(256 * pn) * RB; u.pm = pm; u.pn = pn; u.kind = 3;
        } else {
            const int pn = L - 900;
            u.a = H; u.b = WT + (size_t)(1024 + 256 * pn) * RB; u.pm = 0; u.pn = pn; u.kind = 4;
        }
        return true;
    }
};
struct SchedOut {
    const char* ws; int c, G;
    __device__ __forceinline__ bool next(int i, pg8::Unit& u) const {
        const int L = i * G + c; if (L >= 256) return false;
        constexpr size_t RB = (size_t)DM * 2;
        int wgid = (L % 8) * 32 + L / 8;
        const int gid = wgid / 64, rem = wgid % 64;
        const int pm = gid * 8 + (rem % 8), pn = rem / 8;
        u.a = ws + WS_MIX + (size_t)(256 * pm) * RB; u.b = ws + WS_WO + (size_t)(256 * pn) * RB; u.pm = pm; u.pn = pn; u.kind = 5;
        return true;
    }
};

struct EpiIn {
    __device__ __forceinline__ void operator()(const f32x4 (&acc)[2][2][4][2], const pg8::Unit& u, int wr, int wc, int fr, int fq) const {
        const int kind = u.kind;
        unsigned char* ws = KWS;
        if (kind == 0 || kind == 4) {
            const bool isq = (kind == 0) && (u.pn < 4);
            const float* gsrc = isq ? KIN(I_QG) : KIN(I_KG);
            const float osc = isq ? QSCALE : 1.0f;
            const f32x2* tab = (const f32x2*)(ws + WS_TAB);
            f32x4 g[2][2];
#pragma unroll
            for (int bj = 0; bj < 2; ++bj)
#pragma unroll
                for (int n = 0; n < 2; ++n) g[bj][n] = *(const f32x4*)(gsrc + 32 * bj + 16 * n + 4 * fq);
            bf16_t* dst = (bf16_t*)(ws + (isq ? WS_Q : WS_K));
            const int rowoff = (kind == 0 && !isq) ? CTXL : 0;
            const int G = 4 * (u.pn & 3) + wc;
#pragma unroll
            for (int ai = 0; ai < 2; ++ai) {
                const int rpos = 4 * u.pm + 2 * ai + wr;
                f32x4 cr0, cr1;
                if (kind == 0) { const f32x4* tp = (const f32x4*)(tab + rpos * 16 + 4 * fq); cr0 = tp[0]; cr1 = tp[1]; }
                else { cr0 = (f32x4){1.f, 0.f, 1.f, 0.f}; cr1 = cr0; }
#pragma unroll
                for (int m = 0; m < 4; ++m) {
                    const int t = 256 * u.pm + 128 * ai + 64 * wr + 16 * m + fr;
                    float ss = 0.f;
#pragma unroll
                    for (int bj = 0; bj < 2; ++bj)
#pragma unroll
                        for (int n = 0; n < 2; ++n) { const f32x4 v = acc[ai][bj][m][n]; ss += (v[0] * v[0] + v[1] * v[1]) + (v[2] * v[2] + v[3] * v[3]); }
                    ss += __shfl_xor(ss, 16); ss += __shfl_xor(ss, 32);
                    const float rstd = __builtin_amdgcn_rsqf(ss * (1.0f / 64.0f) + EPS) * osc;
                    f32x4 cc0, cc1;
                    if (kind == 0) { const f32x4* tp = (const f32x4*)(tab + (16 * m + fr) * 16 + 4 * fq); cc0 = tp[0]; cc1 = tp[1]; }
                    else { cc0 = (f32x4){1.f, 0.f, 1.f, 0.f}; cc1 = cc0; }
                    bf16_t* rowp = dst + (size_t)(rowoff + t) * 1024 + G * 64 + 8 * fq;
#pragma unroll
                    for (int bj = 0; bj < 2; ++bj) {
                        const f32x4 x1 = acc[ai][bj][m][0] * g[bj][0] * rstd, x2 = acc[ai][bj][m][1] * g[bj][1] * rstd;
                        const f32x4 ca = bj == 0 ? cr0 : cc0, cb = bj == 0 ? cr1 : cc1;
                        const float co[4] = {ca[0], ca[2], cb[0], cb[2]}, si[4] = {ca[1], ca[3], cb[1], cb[3]};
                        float o1[4], o2[4];
#pragma unroll
                        for (int e = 0; e < 4; ++e) { o1[e] = x1[e] * co[e] - x2[e] * si[e]; o2[e] = x2[e] * co[e] + x1[e] * si[e]; }
                        u32x4 w; w.x = cvtpk(o1[0], o1[1]); w.y = cvtpk(o1[2], o1[3]); w.z = cvtpk(o2[0], o2[1]); w.w = cvtpk(o2[2], o2[3]);
                        *(u32x4*)(rowp + 32 * bj) = w;
                    }
                }
            }
        } else if (kind == 1) {
            const bool isa = u.pn < 12; const int pnl = isa ? (u.pn - 8) : (u.pn - 20);
            bf16_t* dst = (bf16_t*)(ws + (isa ? WS_GA : WS_GC));
#pragma unroll
            for (int ai = 0; ai < 2; ++ai)
#pragma unroll
                for (int m = 0; m < 4; ++m) {
                    const int t = 256 * u.pm + 128 * ai + 64 * wr + 16 * m + fr;
                    bf16_t* rowp = dst + (size_t)t * 1024 + 256 * pnl + 32 * wc + 8 * fq;
#pragma unroll
                    for (int bj = 0; bj < 2; ++bj) {
                        const f32x4 v0 = acc[ai][bj][m][0], v1 = acc[ai][bj][m][1];
                        u32x4 w; w.x = cvtpk(silu_f(v0[0]), silu_f(v0[1])); w.y = cvtpk(silu_f(v0[2]), silu_f(v0[3]));
                        w.z = cvtpk(silu_f(v1[0]), silu_f(v1[1])); w.w = cvtpk(silu_f(v1[2]), silu_f(v1[3]));
                        *(u32x4*)(rowp + 128 * bj) = w;
                    }
                }
        } else if (kind == 2) {
            const int pnl = u.pn - 12;
            bf16_t* Y = (bf16_t*)(ws + WS_Y);
#pragma unroll
            for (int ai = 0; ai < 2; ++ai)
#pragma unroll
                for (int m = 0; m < 4; ++m) {
                    const int t = 256 * u.pm + 128 * ai + 64 * wr + 16 * m + fr;
                    bf16_t* rowp = Y + (size_t)t * 1024 + 128 * pnl + 32 * wc + 8 * fq;
                    const f32x4 a0 = acc[ai][0][m][0], a1 = acc[ai][0][m][1], g0 = acc[ai][1][m][0], g1 = acc[ai][1][m][1];
                    u32x4 w; w.x = cvtpk(a0[0] * sigmoid_f(g0[0]), a0[1] * sigmoid_f(g0[1])); w.y = cvtpk(a0[2] * sigmoid_f(g0[2]), a0[3] * sigmoid_f(g0[3]));
                    w.z = cvtpk(a1[0] * sigmoid_f(g1[0]), a1[1] * sigmoid_f(g1[1])); w.w = cvtpk(a1[2] * sigmoid_f(g1[2]), a1[3] * sigmoid_f(g1[3]));
                    *(u32x4*)rowp = w;
                }
        } else {
            const int sfq = (fq == 1) ? 2 : ((fq == 2) ? 1 : fq);
            bf16_t* VT = (bf16_t*)(ws + WS_VT);
#pragma unroll
            for (int ai = 0; ai < 2; ++ai)
#pragma unroll
                for (int m = 0; m < 4; ++m) {
                    const int f = 256 * u.pm + 128 * ai + 64 * wr + 16 * m + fr;
                    bf16_t* rowp = VT + (size_t)f * NTOK + 256 * u.pn + 32 * wc + 4 * sfq;
#pragma unroll
                    for (int bj = 0; bj < 2; ++bj)
#pragma unroll
                        for (int n = 0; n < 2; ++n) { const f32x4 v = acc[ai][bj][m][n]; u32x2 w; w.x = cvtpk(v[0], v[1]); w.y = cvtpk(v[2], v[3]); *(u32x2*)(rowp + 128 * bj + 16 * n) = w; }
                }
        }
    }
};
struct EpiOut {
    __device__ __forceinline__ void operator()(const f32x4 (&acc)[2][2][4][2], const pg8::Unit& u, int wr, int wc, int fr, int fq) const {
        const float* gate = (const float*)(KWS + WS_MOD) + 4096; const float* gb = KIN(I_BADA) + 4096;
        const float* x = KIN(I_X); float* out = KOUT;
        const int col0 = 256 * u.pn + 32 * wc + 4 * fq;
        f32x4 gv[2][2];
#pragma unroll
        for (int bj = 0; bj < 2; ++bj)
#pragma unroll
            for (int n = 0; n < 2; ++n) gv[bj][n] = *(const f32x4*)(gate + col0 + 128 * bj + 16 * n) + *(const f32x4*)(gb + col0 + 128 * bj + 16 * n);
#pragma unroll
        for (int ai = 0; ai < 2; ++ai)
#pragma unroll
            for (int mh = 0; mh < 2; ++mh) {
                f32x4 xv[2][2][2];
#pragma unroll
                for (int mm = 0; mm < 2; ++mm) {
                    const size_t off = (size_t)(256 * u.pm + 128 * ai + 64 * wr + 16 * (2 * mh + mm) + fr) * DM + col0;
#pragma unroll
                    for (int bj = 0; bj < 2; ++bj)
#pragma unroll
                        for (int n = 0; n < 2; ++n) xv[mm][bj][n] = *(const f32x4*)(x + off + 128 * bj + 16 * n);
                }
#pragma unroll
                for (int mm = 0; mm < 2; ++mm) {
                    const size_t off = (size_t)(256 * u.pm + 128 * ai + 64 * wr + 16 * (2 * mh + mm) + fr) * DM + col0;
#pragma unroll
                    for (int bj = 0; bj < 2; ++bj)
#pragma unroll
                        for (int n = 0; n < 2; ++n) *(f32x4*)(out + off + 128 * bj + 16 * n) = xv[mm][bj][n] + gv[bj][n] * acc[ai][bj][2 * mh + mm][n];
                }
            }
    }
};

__device__ __forceinline__ int win_dest_row(int s) {
    if (s < 2048) { const int base = s & ~1023, ss = s & 1023, G = ss >> 6, d = ss & 63; return base + 256 * (G >> 2) + 128 * (d >> 5) + 32 * (G & 3) + (d & 31); }
    if (s < 3072) return 6144 + (s - 2048);
    if (s < 4096) { const int f = s - 3072; return 2048 + (f & ~31) + perm5(f & 31); }
    if (s < 6144) { const int isg = s >= 5120 ? 1 : 0, ch = s - 4096 - 1024 * isg; return 3072 + 256 * (ch >> 7) + 128 * isg + (ch & 96) + perm5(ch & 31); }
    const int f = s - 6144; return 5120 + (f & ~31) + perm5(f & 31);
}
__device__ __forceinline__ void transpose_item(const float* W, int N, bf16_t* WT, int k0, int n0, bool is_in, LAS float* scr, int lane) {
    const int lr = lane >> 4, lc = (lane & 15) * 4;
    f32x4 v[16];
#pragma unroll
    for (int i = 0; i < 16; ++i) v[i] = *(const f32x4*)(W + (size_t)(k0 + 4 * i + lr) * N + n0 + lc);
#pragma unroll
    for (int i = 0; i < 16; ++i) { LAS float* d = scr + (4 * i + lr) * 65 + lc; d[0] = v[i][0]; d[1] = v[i][1]; d[2] = v[i][2]; d[3] = v[i][3]; }
    asm volatile("s_waitcnt lgkmcnt(0)" ::: "memory");
    const int c = lane & 7;
#pragma unroll
    for (int j = 0; j < 8; ++j) {
        const int n = (lane >> 3) + 8 * j; const LAS float* s = scr + (8 * c) * 65 + n;
        u32x4 o; o.x = cvtpk(s[0 * 65], s[1 * 65]); o.y = cvtpk(s[2 * 65], s[3 * 65]); o.z = cvtpk(s[4 * 65], s[5 * 65]); o.w = cvtpk(s[6 * 65], s[7 * 65]);
        const int dr = is_in ? win_dest_row(n0 + n) : (n0 + n);
        *(u32x4*)(WT + (size_t)dr * DM + k0 + 8 * c) = o;
    }
    asm volatile("s_waitcnt lgkmcnt(0)" ::: "memory");
}

__device__ __forceinline__ void phase0(LAS unsigned char* lds, int bx, int G, int lane, int wave) {
    unsigned char* ws = KWS;
    const float* w_ada = KIN(I_WADA); const float* cv = KIN(I_C); const float* ccv = KIN(I_CCTX);
    float* modx = (float*)(ws + WS_MOD);
    LAS float* red = (LAS float*)lds;
    for (int wi = bx; wi < 256; wi += G) {
        const int cc = wi & 31, kb = ((wi >> 5) * 8 + wave) * 32, cb = cc * 192 + lane * 4;
        f32x4 ax = {0.f, 0.f, 0.f, 0.f}, ac = {0.f, 0.f, 0.f, 0.f};
        if (lane < 48) {
#pragma unroll
            for (int k = 0; k < 32; ++k) {
                const f32x4 w = *(const f32x4*)(w_ada + (size_t)(kb + k) * 6144 + cb);
                const float sx = silu_f(cv[kb + k]), sc = silu_f(ccv[kb + k]);
                ax += w * sx; ac += w * sc;
            }
            *(LAS f32x4*)(red + (wave * 2 + 0) * 192 + lane * 4) = ax;
            *(LAS f32x4*)(red + (wave * 2 + 1) * 192 + lane * 4) = ac;
        }
        __syncthreads();
        {
            const int t = threadIdx.x;
            if (t < 384) {
                const int vec = t / 192, col = t - vec * 192;
                float s = 0.f;
#pragma unroll
                for (int w = 0; w < 8; ++w) s += red[(w * 2 + vec) * 192 + col];
                unsafeAtomicAdd(modx + vec * 6144 + cc * 192 + col, s);
            }
        }
        __syncthreads();
    }
    asm volatile("s_waitcnt vmcnt(0)" ::: "memory");
    __syncthreads();
    if (threadIdx.x == 0) __hip_atomic_fetch_add((unsigned*)(ws + WS_P0CNT), 1u, __ATOMIC_RELAXED, __HIP_MEMORY_SCOPE_AGENT);
    {
        const int gt = (bx * 8 + wave) * 64 + lane;
        if (gt < 2048) {
            const int p = gt >> 4, f = gt & 15;
            const float inv = exp2f(-(float)f * (13.287712379549449f / 16.0f));
            const float ang = (float)p * inv;
            float rev = ang * 0.15915494309189535f; rev -= floorf(rev);
            ((f32x2*)(ws + WS_TAB))[gt] = (f32x2){__builtin_amdgcn_cosf(rev), __builtin_amdgcn_sinf(rev)};
        }
    }
}

__device__ __forceinline__ void phase1(LAS unsigned char* lds, int gw, int NGW, int lane, int wave) {
    unsigned char* ws = KWS;
    {
        LAS float* scr = (LAS float*)(lds + wave * 16640);
        const float* w_in = KIN(I_WIN); const float* w_out = KIN(I_WOUT);
        bf16_t* WT = (bf16_t*)(ws + WS_WT); bf16_t* WO = (bf16_t*)(ws + WS_WO);
        constexpr int NB_IN = INW / 64, NB_OUT = DM / 64, I_IN = 32 * NB_IN, I_OUT = 32 * NB_OUT;
        const int n_items = (NGW == 2048) ? I_IN : I_IN + I_OUT;
        for (int it = (NGW - 1 - gw); it < n_items; it += NGW) {
            if (it < I_IN) { const int kb = it / NB_IN, nb = it % NB_IN; transpose_item(w_in, INW, WT, kb * 64, nb * 64, true, scr, lane); }
            else { const int r2 = it - I_IN, kb = r2 / NB_OUT, nb = r2 % NB_OUT; transpose_item(w_out, DM, WO, kb * 64, nb * 64, false, scr, lane); }
        }
    }
    if (threadIdx.x == 0) {
        unsigned* cnt = (unsigned*)(ws + WS_P0CNT); const unsigned want = gridDim.x; unsigned spins = 0;
        while (__hip_atomic_load(cnt, __ATOMIC_RELAXED, __HIP_MEMORY_SCOPE_AGENT) < want) { __builtin_amdgcn_s_sleep(2); if (++spins > (1u << 20)) break; }
    }
    __syncthreads();
    const float* x = KIN(I_X); const float* ctx = KIN(I_CTX);
    {
        const float* b_ada = KIN(I_BADA); const float* norm_g = KIN(I_NORMG);
        float* modx = (float*)(ws + WS_MOD); float* modc = modx + 6144;
        const int col = threadIdx.x * 4;
        const f32x4 g = *(const f32x4*)(norm_g + col), bsh = *(const f32x4*)(b_ada + col), bsc = *(const f32x4*)(b_ada + 2048 + col);
        f32x4 sx, hx, sc, hc;
#pragma unroll
        for (int e = 0; e < 4; ++e) {
            sx[e] = __hip_atomic_load(modx + 2048 + col + e, __ATOMIC_RELAXED, __HIP_MEMORY_SCOPE_AGENT); hx[e] = __hip_atomic_load(modx + col + e, __ATOMIC_RELAXED, __HIP_MEMORY_SCOPE_AGENT);
            sc[e] = __hip_atomic_load(modc + 2048 + col + e, __ATOMIC_RELAXED, __HIP_MEMORY_SCOPE_AGENT); hc[e] = __hip_atomic_load(modc + col + e, __ATOMIC_RELAXED, __HIP_MEMORY_SCOPE_AGENT);
        }
        *(LAS f32x4*)(lds + 0 * 8192 + col * 4) = g * (1.0f + sx + bsc);
        *(LAS f32x4*)(lds + 1 * 8192 + col * 4) = hx + bsh;
        *(LAS f32x4*)(lds + 2 * 8192 + col * 4) = g * (1.0f + sc + bsc);
        *(LAS f32x4*)(lds + 3 * 8192 + col * 4) = hc + bsh;
    }
    __syncthreads();
    bf16_t* H = (bf16_t*)(ws + WS_H);
    f32x4 cur[8], nxt[8];
    int r = gw;
    if (r < NTOK) {
        const float* src = (r < CTXL) ? ctx + (size_t)r * DM : x + (size_t)(r - CTXL) * DM;
#pragma unroll
        for (int j = 0; j < 8; ++j) cur[j] = *(const f32x4*)(src + (lane + 64 * j) * 4);
    }
    for (; r < NTOK; r += NGW) {
        const int rn = r + NGW;
        if (rn < NTOK) {
            const float* src = (rn < CTXL) ? ctx + (size_t)rn * DM : x + (size_t)(rn - CTXL) * DM;
#pragma unroll
            for (int j = 0; j < 8; ++j) nxt[j] = *(const f32x4*)(src + (lane + 64 * j) * 4);
        }
        float ss = 0.f;
#pragma unroll
        for (int j = 0; j < 8; ++j) ss += (cur[j][0] * cur[j][0] + cur[j][1] * cur[j][1]) + (cur[j][2] * cur[j][2] + cur[j][3] * cur[j][3]);
        const float rstd = __builtin_amdgcn_rsqf(wave_sum(ss) * (1.0f / DM) + EPS);
        const int sel = (r < CTXL) ? 2 * 8192 : 0;
        bf16_t* dst = H + (size_t)r * DM;
#pragma unroll
        for (int j = 0; j < 8; ++j) {
            const int col = (lane + 64 * j) * 4;
            const f32x4 ge = *(const LAS f32x4*)(lds + sel + col * 4), sh = *(const LAS f32x4*)(lds + sel + 8192 + col * 4);
            const f32x4 o = cur[j] * rstd * ge + sh;
            u32x2 w; w.x = cvtpk(o[0], o[1]); w.y = cvtpk(o[2], o[3]);
            *(u32x2*)(dst + col) = w;
        }
#pragma unroll
        for (int j = 0; j < 8; ++j) cur[j] = nxt[j];
    }
    __syncthreads();
}

constexpr int AT_KBYTES = 16384, AT_VBYTES = 16384, AT_BUF = AT_KBYTES + AT_VBYTES;
constexpr int AT_XOFF = 0;
constexpr int AT_NT = NTOK / 64;
static_assert(4 * AT_BUF <= LDS_BYTES - 64, "attention ring");

__device__ __forceinline__ void attn_unit(unsigned char* ws, const float* sub_g, LAS unsigned char* lds, int h, int qb, float negM, float lam) {
    const int tid = threadIdx.x, lane = tid & 63, r32 = lane & 31, hi = lane >> 5;
    const int wid = __builtin_amdgcn_readfirstlane(tid >> 6), map = wid >> 2, wq = wid & 3;
    const int qrow0 = qb * 128 + 32 * wq;
    const bf16_t* Qp = (const bf16_t*)(ws + WS_Q); const bf16_t* Kp = (const bf16_t*)(ws + WS_K); const bf16_t* VTp = (const bf16_t*)(ws + WS_VT);
    bf16x8 qf[4];
    {
        const bf16_t* qp = Qp + (size_t)(qrow0 + r32) * 1024 + (h * 2 + map) * 64 + 8 * hi;
#pragma unroll
        for (int d0 = 0; d0 < 4; ++d0) qf[d0] = *(const bf16x8*)(qp + 16 * d0);
    }
    const bf16_t* kg[2]; const bf16_t* vg[2];
#pragma unroll
    for (int i = 0; i < 2; ++i) {
        const int g = 2 * wid + i;
        const int kr = 4 * g + (lane >> 4), kc = (lane & 15) ^ (kr & 15);
        kg[i] = Kp + (size_t)kr * 1024 + h * 128 + kc * 8;
        const int vr = 8 * g + (lane >> 3), vc = (lane & 7) ^ ((vr >> 1) & 7);
        vg[i] = VTp + (size_t)(h * 128 + vr) * NTOK + vc * 8;
    }
    const unsigned dmaoff = (unsigned)wid * 2048u;
#define AT_DMA(B) do { _Pragma("unroll") for (int i_ = 0; i_ < 2; ++i_) { \
        __builtin_amdgcn_global_load_lds((const unsigned*)kg[i_], (LAS unsigned*)(lds + (B) + dmaoff + i_ * 1024), 16, 0, 0); \
        __builtin_amdgcn_global_load_lds((const unsigned*)vg[i_], (LAS unsigned*)(lds + (B) + AT_KBYTES + dmaoff + i_ * 1024), 16, 0, 0); } } while (0)
#define AT_ADV() do { kg[0] += 64 * 1024; kg[1] += 64 * 1024; vg[0] += 64; vg[1] += 64; } while (0)
    int kad[4], vad[4];
#pragma unroll
    for (int d0 = 0; d0 < 4; ++d0) kad[d0] = r32 * 256 + (((map * 8 + 2 * d0 + hi) ^ (r32 & 15)) << 4);
#pragma unroll
    for (int j = 0; j < 4; ++j) vad[j] = AT_KBYTES + r32 * 128 + (((2 * j + hi) ^ ((r32 >> 1) & 7)) << 4);
#define SB() __builtin_amdgcn_sched_barrier(0)
#define KFR(B, d0, kh) (*(const LAS bf16x8*)(lds + (B) + kad[d0] + (kh) * 8192))
#define VFR(B, j, b) (*(const LAS bf16x8*)(lds + (B) + vad[j] + (b) * 4096))
    f32x16 o[4];
#pragma unroll
    for (int b = 0; b < 4; ++b)
#pragma unroll
        for (int r = 0; r < 16; ++r) o[b][r] = 0.f;
    f32x16 negm;
#pragma unroll
    for (int r = 0; r < 16; ++r) negm[r] = negM;
    float l0 = 0.f, l1 = 0.f;
    AT_DMA(0); AT_ADV(); AT_DMA(AT_BUF); AT_ADV();
    asm volatile("s_waitcnt vmcnt(0)" ::: "memory");
    __builtin_amdgcn_s_barrier();
    AT_DMA(2 * AT_BUF); AT_ADV();
    f32x16 pa, pb;
    {
        f32x16 s0 = negm, s1 = negm;
#pragma unroll
        for (int d0 = 0; d0 < 4; ++d0) { s0 = __builtin_amdgcn_mfma_f32_32x32x16_bf16(KFR(0, d0, 0), qf[d0], s0, 0, 0, 0); s1 = __builtin_amdgcn_mfma_f32_32x32x16_bf16(KFR(0, d0, 1), qf[d0], s1, 0, 0, 0); }
#pragma unroll
        for (int r = 0; r < 16; ++r) { pa[r] = __builtin_amdgcn_exp2f(s0[r]); pb[r] = __builtin_amdgcn_exp2f(s1[r]); }
    }
    asm volatile("s_waitcnt vmcnt(0) lgkmcnt(0)" ::: "memory");
    __builtin_amdgcn_s_barrier();
    int bV = 0, bK = AT_BUF, bN = 2 * AT_BUF, bW = 3 * AT_BUF;
    u32x4 pw[4];
    bf16x8 F0 = *(const LAS bf16x8*)(lds + AT_BUF + kad[0]), F1 = *(const LAS bf16x8*)(lds + AT_BUF + kad[0] + 8192), F2;
    for (int t = 1; t < AT_NT; ++t) {
        AT_DMA(bW);
        if (t + 3 < AT_NT) AT_ADV();
        SB();
#define FADDR(i) (((i) < 8) ? (bK + kad[(i) >> 1] + ((i) & 1) * 8192) : ((i) < 24) ? (bV + vad[((i) - 8) >> 2] + (((i) - 8) & 3) * 4096) : (bN + kad[0] + ((i) - 24) * 8192))
#define FLOAD(i) (*(const LAS bf16x8*)(lds + FADDR(i)))
#define ADD4(P, base) do { l0 = fadd_s(l0, P[base]); l1 = fadd_s(l1, P[base + 1]); l0 = fadd_s(l0, P[base + 2]); l1 = fadd_s(l1, P[base + 3]); } while (0)
#define EXP2(S, P, base) do { P[base] = __builtin_amdgcn_exp2f(S[base]); P[base + 1] = __builtin_amdgcn_exp2f(S[base + 1]); } while (0)
        f32x16 s0, s1;
        F2 = FLOAD(2); s0 = __builtin_amdgcn_mfma_f32_32x32x16_bf16(F0, qf[0], negm, 0, 0, 0); ADD4(pa, 0); pw[0][0] = cvtpk(pa[0], pa[1]); SB();
        F0 = FLOAD(3); s1 = __builtin_amdgcn_mfma_f32_32x32x16_bf16(F1, qf[0], negm, 0, 0, 0); ADD4(pa, 4); pw[0][1] = cvtpk(pa[2], pa[3]); SB();
        F1 = FLOAD(4); s0 = __builtin_amdgcn_mfma_f32_32x32x16_bf16(F2, qf[1], s0, 0, 0, 0); ADD4(pa, 8); pw[0][2] = cvtpk(pa[4], pa[5]); SB();
        F2 = FLOAD(5); s1 = __builtin_amdgcn_mfma_f32_32x32x16_bf16(F0, qf[1], s1, 0, 0, 0); ADD4(pa, 12); pw[0][3] = cvtpk(pa[6], pa[7]); SB();
        F0 = FLOAD(6); s0 = __builtin_amdgcn_mfma_f32_32x32x16_bf16(F1, qf[2], s0, 0, 0, 0); ADD4(pb, 0); pw[1][0] = cvtpk(pa[8], pa[9]); SB();
        F1 = FLOAD(7); s1 = __builtin_amdgcn_mfma_f32_32x32x16_bf16(F2, qf[2], s1, 0, 0, 0); ADD4(pb, 4); pw[1][1] = cvtpk(pa[10], pa[11]); SB();
        F2 = FLOAD(8); s0 = __builtin_amdgcn_mfma_f32_32x32x16_bf16(F0, qf[3], s0, 0, 0, 0); ADD4(pb, 8); pw[1][2] = cvtpk(pa[12], pa[13]); SB();
        F0 = FLOAD(9); s1 = __builtin_amdgcn_mfma_f32_32x32x16_bf16(F1, qf[3], s1, 0, 0, 0); ADD4(pb, 12); pw[1][3] = cvtpk(pa[14], pa[15]); SB();
        F1 = FLOAD(10); o[0] = __builtin_amdgcn_mfma_f32_32x32x16_bf16(F2, __builtin_bit_cast(bf16x8, pw[0]), o[0], 0, 0, 0); pw[2][0] = cvtpk(pb[0], pb[1]); EXP2(s0, pa, 0); SB();
        F2 = FLOAD(11); o[1] = __builtin_amdgcn_mfma_f32_32x32x16_bf16(F0, __builtin_bit_cast(bf16x8, pw[0]), o[1], 0, 0, 0); pw[2][1] = cvtpk(pb[2], pb[3]); EXP2(s0, pa, 2); SB();
        F0 = FLOAD(12); o[2] = __builtin_amdgcn_mfma_f32_32x32x16_bf16(F1, __builtin_bit_cast(bf16x8, pw[0]), o[2], 0, 0, 0); pw[2][2] = cvtpk(pb[4], pb[5]); EXP2(s0, pa, 4); SB();
        F1 = FLOAD(13); o[3] = __builtin_amdgcn_mfma_f32_32x32x16_bf16(F2, __builtin_bit_cast(bf16x8, pw[0]), o[3], 0, 0, 0); pw[2][3] = cvtpk(pb[6], pb[7]); EXP2(s0, pa, 6); SB();
        F2 = FLOAD(14); o[0] = __builtin_amdgcn_mfma_f32_32x32x16_bf16(F0, __builtin_bit_cast(bf16x8, pw[1]), o[0], 0, 0, 0); pw[3][0] = cvtpk(pb[8], pb[9]); EXP2(s0, pa, 8); SB();
        F0 = FLOAD(15); o[1] = __builtin_amdgcn_mfma_f32_32x32x16_bf16(F1, __builtin_bit_cast(bf16x8, pw[1]), o[1], 0, 0, 0); pw[3][1] = cvtpk(pb[10], pb[11]); EXP2(s0, pa, 10); SB();
        F1 = FLOAD(16); o[2] = __builtin_amdgcn_mfma_f32_32x32x16_bf16(F2, __builtin_bit_cast(bf16x8, pw[1]), o[2], 0, 0, 0); pw[3][2] = cvtpk(pb[12], pb[13]); EXP2(s0, pa, 12); SB();
        F2 = FLOAD(17); o[3] = __builtin_amdgcn_mfma_f32_32x32x16_bf16(F0, __builtin_bit_cast(bf16x8, pw[1]), o[3], 0, 0, 0); pw[3][3] = cvtpk(pb[14], pb[15]); EXP2(s0, pa, 14); SB();
        F0 = FLOAD(18); o[0] = __builtin_amdgcn_mfma_f32_32x32x16_bf16(F1, __builtin_bit_cast(bf16x8, pw[2]), o[0], 0, 0, 0); EXP2(s1, pb, 0); SB();
        F1 = FLOAD(19); o[1] = __builtin_amdgcn_mfma_f32_32x32x16_bf16(F2, __builtin_bit_cast(bf16x8, pw[2]), o[1], 0, 0, 0); EXP2(s1, pb, 2); SB();
        F2 = FLOAD(20); o[2] = __builtin_amdgcn_mfma_f32_32x32x16_bf16(F0, __builtin_bit_cast(bf16x8, pw[2]), o[2], 0, 0, 0); EXP2(s1, pb, 4); SB();
        F0 = FLOAD(21); o[3] = __builtin_amdgcn_mfma_f32_32x32x16_bf16(F1, __builtin_bit_cast(bf16x8, pw[2]), o[3], 0, 0, 0); EXP2(s1, pb, 6); SB();
        F1 = FLOAD(22); o[0] = __builtin_amdgcn_mfma_f32_32x32x16_bf16(F2, __builtin_bit_cast(bf16x8, pw[3]), o[0], 0, 0, 0); EXP2(s1, pb, 8); SB();
        F2 = FLOAD(23); o[1] = __builtin_amdgcn_mfma_f32_32x32x16_bf16(F0, __builtin_bit_cast(bf16x8, pw[3]), o[1], 0, 0, 0); EXP2(s1, pb, 10); SB();
        F0 = FLOAD(24); o[2] = __builtin_amdgcn_mfma_f32_32x32x16_bf16(F1, __builtin_bit_cast(bf16x8, pw[3]), o[2], 0, 0, 0); EXP2(s1, pb, 12); SB();
        F1 = FLOAD(25); o[3] = __builtin_amdgcn_mfma_f32_32x32x16_bf16(F2, __builtin_bit_cast(bf16x8, pw[3]), o[3], 0, 0, 0); EXP2(s1, pb, 14); SB();
#undef ADD4
#undef EXP2
#undef FADDR
#undef FLOAD
        asm volatile("s_waitcnt vmcnt(0) lgkmcnt(0)" ::: "memory");
        __builtin_amdgcn_s_barrier();
        const int tmp = bV; bV = bK; bK = bN; bN = bW; bW = tmp;
    }
    {
        float a0 = 0.f, a1 = 0.f;
#pragma unroll
        for (int r = 0; r < 16; ++r) { a0 += pa[r]; a1 += pb[r]; }
        l0 += a0; l1 += a1;
        pw[0] = (u32x4){cvtpk(pa[0], pa[1]), cvtpk(pa[2], pa[3]), cvtpk(pa[4], pa[5]), cvtpk(pa[6], pa[7])};
        pw[1] = (u32x4){cvtpk(pa[8], pa[9]), cvtpk(pa[10], pa[11]), cvtpk(pa[12], pa[13]), cvtpk(pa[14], pa[15])};
        pw[2] = (u32x4){cvtpk(pb[0], pb[1]), cvtpk(pb[2], pb[3]), cvtpk(pb[4], pb[5]), cvtpk(pb[6], pb[7])};
        pw[3] = (u32x4){cvtpk(pb[8], pb[9]), cvtpk(pb[10], pb[11]), cvtpk(pb[12], pb[13]), cvtpk(pb[14], pb[15])};
#pragma unroll
        for (int j = 0; j < 4; ++j)
#pragma unroll
            for (int b = 0; b < 4; ++b) o[b] = __builtin_amdgcn_mfma_f32_32x32x16_bf16(VFR(bV, j, b), __builtin_bit_cast(bf16x8, pw[j]), o[b], 0, 0, 0);
    }
    float l = l0 + l1;
#undef AT_DMA
#undef AT_ADV
#undef SB
#undef KFR
#undef VFR
    asm volatile("s_waitcnt vmcnt(0) lgkmcnt(0)" ::: "memory");
    __builtin_amdgcn_s_barrier();
    l += __shfl_xor(l, 32);
    const float inv = 1.0f / l;
    LAS float* xw = (LAS float*)(lds + AT_XOFF + wq * 16384);
    if (map == 1) {
        const float f = inv * lam;
#pragma unroll
        for (int b = 0; b < 4; ++b)
#pragma unroll
            for (int r = 0; r < 16; ++r) xw[(b * 16 + r) * 64 + lane] = o[b][r] * f;
    }
    __syncthreads();
    if (map == 0) {
        float ss = 0.f;
#pragma unroll
        for (int b = 0; b < 4; ++b)
#pragma unroll
            for (int r = 0; r < 16; ++r) { const float v = o[b][r] * inv - xw[(b * 16 + r) * 64 + lane]; o[b][r] = v; ss += v * v; }
        ss += __shfl_xor(ss, 32);
        const float rs = __builtin_amdgcn_rsqf(ss * (1.0f / VD) + EPS) * (1.0f - LAM_INIT);
        LAS unsigned char* stg = (LAS unsigned char*)xw;
#pragma unroll
        for (int b = 0; b < 4; ++b)
#pragma unroll
            for (int r4 = 0; r4 < 4; ++r4) {
                const int dv = 32 * b + 8 * r4 + 4 * hi;
                const f32x4 sg = *(const f32x4*)(sub_g + dv);
                u32x2 w; w.x = cvtpk(o[b][4 * r4 + 0] * rs * sg[0], o[b][4 * r4 + 1] * rs * sg[1]); w.y = cvtpk(o[b][4 * r4 + 2] * rs * sg[2], o[b][4 * r4 + 3] * rs * sg[3]);
                *(LAS u32x2*)(stg + r32 * 272 + dv * 2) = w;
            }
        asm volatile("s_waitcnt lgkmcnt(0)" ::: "memory");
        const bf16_t* GA = (const bf16_t*)(ws + WS_GA); bf16_t* MIX = (bf16_t*)(ws + WS_MIX);
        u32x4 gvs[8];
#pragma unroll
        for (int i = 0; i < 8; ++i) gvs[i] = *(const u32x4*)(GA + (size_t)(qrow0 + (lane >> 4) + 4 * i) * 1024 + h * 128 + (lane & 15) * 8);
#pragma unroll
        for (int i = 0; i < 8; ++i) {
            const int q = (lane >> 4) + 4 * i, ch = lane & 15;
            const u32x4 ov = *(const LAS u32x4*)(stg + q * 272 + ch * 16);
            const size_t tok = (size_t)(qrow0 + q);
            const u32x4 gv = gvs[i];
            u32x4 w;
            w.x = cvtpk(bf_lo(ov.x) * bf_lo(gv.x), bf_hi(ov.x) * bf_hi(gv.x)); w.y = cvtpk(bf_lo(ov.y) * bf_lo(gv.y), bf_hi(ov.y) * bf_hi(gv.y));
            w.z = cvtpk(bf_lo(ov.z) * bf_lo(gv.z), bf_hi(ov.z) * bf_hi(gv.z)); w.w = cvtpk(bf_lo(ov.w) * bf_lo(gv.w), bf_hi(ov.w) * bf_hi(gv.w));
            *(u32x4*)(MIX + tok * DM + h * 128 + ch * 8) = w;
        }
    }
    __syncthreads();
}

__device__ __forceinline__ void conv_unit(unsigned char* ws, LAS unsigned char* lds, int t0) {
    const int tid = threadIdx.x, lane = tid & 63, wid = tid >> 6, c0 = 2 * tid;
    const float* conv_w = KIN(I_CONVW); const float* conv_b = KIN(I_CONVB);
    const bf16_t* Y = (const bf16_t*)(ws + WS_Y);
    float y0[62], y1[62];
#pragma unroll
    for (int r = 0; r < 62; ++r) {
        const int row = t0 - 15 + r;
        unsigned yv = 0u;
        if (row >= 0 && row < SEQ) yv = *(const unsigned*)(Y + (size_t)row * CONVW + c0);
        y0[r] = bf_lo(yv); y1[r] = bf_hi(yv);
    }
    const f32x2 bias = *(const f32x2*)(conv_b + c0);
    float a0[32], a1[32];
#pragma unroll
    for (int t = 0; t < 32; ++t) { a0[t] = bias[0]; a1[t] = bias[1]; }
#pragma unroll
    for (int j = 0; j < CONVK; ++j) {
        const f32x2 w = *(const f32x2*)(conv_w + j * CONVW + c0);
#pragma unroll
        for (int t = 0; t < 32; ++t) { a0[t] += w[0] * y0[t + j]; a1[t] += w[1] * y1[t + j]; }
    }
    const bf16_t* GC = (const bf16_t*)(ws + WS_GC);
    unsigned gcv[32];
#pragma unroll
    for (int t = 0; t < 32; ++t) gcv[t] = *(const unsigned*)(GC + (size_t)(t0 + t) * CONVW + c0);
    float v[64];
#pragma unroll
    for (int t = 0; t < 32; ++t) { v[t] = a0[t] + a1[t]; v[32 + t] = a0[t] * a0[t] + a1[t] * a1[t]; }
#pragma unroll
    for (int h = 32; h >= 1; h >>= 1) {
        const bool up = (lane & h) != 0;
#pragma unroll
        for (int i = 0; i < h; ++i) {
            const float send = up ? v[i] : v[i + h], keep = up ? v[i + h] : v[i];
            v[i] = keep + __shfl_xor(send, h);
        }
    }
    LAS float* red = (LAS float*)lds;
    LAS float* stat = red + 512;
    red[wid * 64 + lane] = v[0];
    __syncthreads();
    if (tid < 32) {
        float s1 = 0.f, s2 = 0.f;
#pragma unroll
        for (int w = 0; w < 8; ++w) { s1 += red[w * 64 + tid]; s2 += red[w * 64 + 32 + tid]; }
        const float mean = s1 * (1.0f / CONVW), var = fmaxf(s2 * (1.0f / CONVW) - mean * mean, 0.f);
        stat[tid * 2] = mean; stat[tid * 2 + 1] = __builtin_amdgcn_rsqf(var + EPS);
    }
    __syncthreads();
    const float* ln_g = KIN(I_LNG); const float* ln_b = KIN(I_LNB);
    bf16_t* MIX = (bf16_t*)(ws + WS_MIX);
    const f32x2 lg = *(const f32x2*)(ln_g + c0), lb = *(const f32x2*)(ln_b + c0);
#pragma unroll
    for (int t = 0; t < 32; ++t) {
        const float mean = stat[t * 2], rstd = stat[t * 2 + 1];
        const float v0 = (a0[t] - mean) * rstd * lg[0] + lb[0], v1 = (a1[t] - mean) * rstd * lg[1] + lb[1];
        const unsigned gc = gcv[t];
        *(unsigned*)(MIX + (size_t)(t0 + t) * DM + ATTW + c0) = cvtpk(silu_f(v0) * bf_lo(gc), silu_f(v1) * bf_hi(gc));
    }
    __syncthreads();
}

#define XB_TMO      128
#define XB_XCNT(j)  (256  + 64 * (j))
#define XB_XSUB(j)  (1280 + 64 * (j))
#define XB_XGEN(j)  (2304 + 64 * (j))
#define XB_TOP      3328
#define XB_TOPGEN   3392
#define XCD_BAR_WORDS 3456
#define XB_SPIN_CAP (1u << 18)
__device__ __forceinline__ unsigned xb_ld(unsigned* p)              { return __hip_atomic_load(p, __ATOMIC_RELAXED, __HIP_MEMORY_SCOPE_AGENT); }
__device__ __forceinline__ unsigned xb_add(unsigned* p, unsigned v) { return __hip_atomic_fetch_add(p, v, __ATOMIC_RELAXED, __HIP_MEMORY_SCOPE_AGENT); }
__device__ __forceinline__ unsigned xb_xcc_id() { return (unsigned)__builtin_amdgcn_s_getreg((3 << 11) | 20) & 0xFu; }
#define XB_SPIN(cond, bar) do { unsigned _sp = 0; while (cond) { __builtin_amdgcn_s_sleep(1); \
    if ((++_sp & 255u) == 0u) { if (xb_ld(&(bar)[XB_TMO])) break; if (_sp > XB_SPIN_CAP) { atomicAdd(&(bar)[XB_TMO], 1u); break; } } } } while (0)
struct XcdBarrier { unsigned* bar; unsigned x; volatile LAS unsigned* st; };
__device__ __forceinline__ XcdBarrier xcd_barrier_post(unsigned* bar, volatile LAS unsigned* st) {
    XcdBarrier b; b.bar = bar; b.x = xb_xcc_id(); b.st = st;
    if (threadIdx.x == 0) st[3] = xb_add(&bar[XB_XCNT(b.x)], 1u);
    return b;
}
__device__ __forceinline__ void xcd_barrier_complete(unsigned* bar, unsigned x, unsigned& nloc, unsigned& nx, unsigned& uni) {
    const unsigned G = gridDim.x * gridDim.y * gridDim.z;
    unsigned sum, cnt, mine, sp = 0u, ok32;
    for (;;) {
        sum = 0u; cnt = 0u; mine = 0u; ok32 = 1u;
#pragma unroll
        for (unsigned j = 0; j < 16; ++j) { const unsigned c = xb_ld(&bar[XB_XCNT(j)]); sum += c; cnt += (c > 0u) ? 1u : 0u; mine = (j == x) ? c : mine; ok32 &= (c == ((j < 8u) ? 32u : 0u)) ? 1u : 0u; }
        if (sum == G) break;
        __builtin_amdgcn_s_sleep(1);
        if ((++sp & 255u) == 0u) { if (xb_ld(&bar[XB_TMO])) break; if (sp > XB_SPIN_CAP) { atomicAdd(&bar[XB_TMO], 1u); break; } }
    }
    nloc = mine > 0u ? mine : 1u; nx = cnt > 0u ? cnt : 1u; uni = (sum == G && G == 256u) ? ok32 : 0u;
}
__device__ __forceinline__ void xcd_barrier(const XcdBarrier& b) {
    asm volatile("s_waitcnt vmcnt(0)" ::: "memory");
    __syncthreads();
    if (threadIdx.x == 0) {
        unsigned* bar = b.bar;
        __builtin_amdgcn_s_waitcnt(0);
        unsigned nloc = b.st[0], nx = b.st[1];
        if (nloc == 0u) { unsigned uni; xcd_barrier_complete(bar, b.x, nloc, nx, uni); b.st[0] = nloc; b.st[1] = nx; b.st[2] = uni; }
        const unsigned old = xb_add(&bar[XB_XSUB(b.x)], 1u);
        const unsigned gen = old / nloc;
        if (old + 1u == (gen + 1u) * nloc) {
            __builtin_amdgcn_fence(__ATOMIC_RELEASE, "agent");
            asm volatile("s_waitcnt vmcnt(0)" ::: "memory");
            const unsigned og = xb_add(&bar[XB_TOP], 1u);
            const unsigned tg = og / nx;
            if (og + 1u == (tg + 1u) * nx) xb_add(&bar[XB_TOPGEN], 1u);
            else XB_SPIN(xb_ld(&bar[XB_TOPGEN]) == tg, bar);
            __builtin_amdgcn_fence(__ATOMIC_ACQUIRE, "agent");
            xb_add(&bar[XB_XGEN(b.x)], 1u);
            asm volatile("s_waitcnt vmcnt(0)" ::: "memory");
        } else {
            XB_SPIN(xb_ld(&bar[XB_XGEN(b.x)]) == gen, bar);
            __builtin_amdgcn_fence(__ATOMIC_ACQUIRE, "agent");
            asm volatile("s_waitcnt vmcnt(0)" ::: "memory");
        }
    }
    __syncthreads();
}

__global__ void __launch_bounds__(512, 2) fwd_kernel(Args args) {
    extern __shared__ __attribute__((aligned(16))) unsigned char lds_raw[];
    LAS unsigned char* lds = (LAS unsigned char*)lds_raw;
    cg::grid_group grid = cg::this_grid();
    const int tid = threadIdx.x, lane = tid & 63, wave = __builtin_amdgcn_readfirstlane(tid >> 6);
    const int G = gridDim.x, bx = blockIdx.x;
    const int gw = bx * 8 + wave, NGW = G * 8;
    const int lo = args.ph_lo, hi = args.ph_hi;
#define IN(k) (lo <= (k) && (k) < hi)
#define BOTH(k) (IN(k) && IN((k) + 1))
    volatile LAS unsigned* bst = (volatile LAS unsigned*)(lds + LDS_BYTES - 64);
    if (tid < 16) bst[tid] = 0u;
    __syncthreads();
    const XcdBarrier gbar = xcd_barrier_post((unsigned*)(KWS + WS_BAR), bst);
    if (lo > 1000) grid.sync();
#define GRID_SYNC() xcd_barrier(gbar)

    if (IN(0)) { phase0(lds, bx, G, lane, wave); __syncthreads(); }
    if (IN(1)) { phase1(lds, gw, NGW, lane, wave); if (BOTH(1)) GRID_SYNC(); }
    int vb = bx;
    if (BOTH(1) && bst[2] != 0u) vb = __builtin_amdgcn_readfirstlane((int)(bst[3] * 8u + gbar.x));
    const bool split2 = (G == 256) && (hi - lo == 5);
    if (IN(2)) {
        EpiIn E;
        if (split2) {
            { SchedIn S{(const char*)KWS, vb, G, 0, 768}; pg8::gemm_phase<EpiIn, SchedIn>(lds, S, E); }
            GRID_SYNC();
            if (vb < 136) { SchedIn S{(const char*)KWS, vb, G, 768, 904}; pg8::gemm_phase<EpiIn, SchedIn>(lds, S, E); }
            else {
                const int j = vb - 136;
                unsigned char* ws = KWS;
                for (int cu = j; cu < SEQ / 32; cu += 120) conv_unit(ws, lds, 32 * cu);
                if (j >= 16) {
                    LAS float* scr = (LAS float*)(lds + wave * 16640);
                    const float* w_out = KIN(I_WOUT); bf16_t* WO = (bf16_t*)(ws + WS_WO);
                    for (int it = (j - 16) * 8 + wave; it < 32 * (DM / 64); it += 104 * 8) { const int kb = it / (DM / 64), nb = it % (DM / 64); transpose_item(w_out, DM, WO, kb * 64, nb * 64, false, scr, lane); }
                }
            }
        } else {
            SchedIn S{(const char*)KWS, vb, G, 0, 904};
            pg8::gemm_phase<EpiIn, SchedIn>(lds, S, E);
            if (G == 256 && vb >= 136) {
                LAS float* scr = (LAS float*)(lds + wave * 16640);
                const float* w_out = KIN(I_WOUT); bf16_t* WO = (bf16_t*)(KWS + WS_WO);
                for (int it = (vb - 136) * 8 + wave; it < 32 * (DM / 64); it += 120 * 8) { const int kb = it / (DM / 64), nb = it % (DM / 64); transpose_item(w_out, DM, WO, kb * 64, nb * 64, false, scr, lane); }
            }
        }
        if (BOTH(2)) GRID_SYNC();
    }
    if (IN(3)) {
        const float* lq1 = KIN(I_LQ1); const float* lk1 = KIN(I_LK1); const float* lq2 = KIN(I_LQ2); const float* lk2 = KIN(I_LK2);
        const float d1 = wave_sum(lq1[lane] * lk1[lane]), d2 = wave_sum(lq2[lane] * lk2[lane]);
        const float lam = __expf(d1) - __expf(d2) + LAM_INIT;
        const float* qg = KIN(I_QG); const float* kg = KIN(I_KG);
        const float mq = wave_max(fabsf(qg[lane])), mk = wave_max(fabsf(kg[lane]));
        const float negM = -(QSCALE * 64.0f * mq * mk * 1.01f);
        unsigned char* ws = KWS;
        if (!split2) for (int t0 = vb * 32; t0 < SEQ; t0 += G * 32) conv_unit(ws, lds, t0);
        const float* sub_g = KIN(I_SUBG);
        for (int u = vb; u < NH * (SEQ / 128); u += G) attn_unit(ws, sub_g, lds, u & 7, u >> 3, negM, lam);
        if (BOTH(3)) GRID_SYNC();
    }
    if (IN(4)) {
        SchedOut S{(const char*)KWS, vb, G};
        EpiOut E;
        pg8::gemm_phase<EpiOut, SchedOut>(lds, S, E);
    }
#undef IN
#undef BOTH
}

extern "C" void kernel_launch(void* const* d_in, const int* in_sizes, int n_in, void* d_out, int out_size, void* d_ws, size_t ws_size, hipStream_t stream) {
    static int grid = 0;
    if (grid == 0) {
        if (n_in != 20 || out_size != SEQ * DM || ws_size < WS_END) { fprintf(stderr, "kernel_launch: unexpected shapes (n_in %d out %d ws %zu)\n", n_in, out_size, ws_size); grid = -1; return; }
        int dev = 0, cus = 0, per_cu = 0;
        if (hipGetDevice(&dev) != hipSuccess || hipDeviceGetAttribute(&cus, hipDeviceAttributeMultiprocessorCount, dev) != hipSuccess) { grid = -1; return; }
        if (hipFuncSetAttribute((const void*)fwd_kernel, hipFuncAttributeMaxDynamicSharedMemorySize, LDS_BYTES) != hipSuccess) { fprintf(stderr, "kernel_launch: hipFuncSetAttribute failed\n"); grid = -1; return; }
        if (hipOccupancyMaxActiveBlocksPerMultiprocessor(&per_cu, (const void*)fwd_kernel, 512, LDS_BYTES) != hipSuccess || per_cu < 1) { fprintf(stderr, "kernel_launch: occupancy query gave %d\n", per_cu); per_cu = 1; }
        (void)hipGetLastError();
        grid = cus * 1;
    }
    if (grid < 0) return;
    (void)hipMemsetAsync((char*)d_ws + WS_MOD, 0, WS_ZERO_BYTES, stream);
    Args a{};
    for (int i = 0; i < 20; ++i) a.in[i] = (const float*)d_in[i];
    a.out = (float*)d_out; a.ws = (unsigned char*)d_ws;
#if MK_N_LAUNCHES == 1
    a.ph_lo = 0; a.ph_hi = 5;
    void* kargs[] = {&a};
    hipError_t e = hipLaunchCooperativeKernel((const void*)fwd_kernel, dim3(grid), dim3(512), kargs, LDS_BYTES, stream);
    if (e != hipSuccess) {
        fprintf(stderr, "cooperative launch failed: %s (grid %d); falling back to one launch per phase\n", hipGetErrorString(e), grid);
        (void)hipGetLastError();
        for (int ph = 0; ph < 5; ++ph) { a.ph_lo = ph; a.ph_hi = ph + 1; hipLaunchKernelGGL(fwd_kernel, dim3(grid), dim3(512), LDS_BYTES, stream, a); }
    }
#else
    for (int ph = 0; ph < 5; ++ph) {
        a.ph_lo = ph; a.ph_hi = ph + 1;
        hipLaunchKernelGGL(fwd_kernel, dim3(grid), dim3(512), LDS_BYTES, stream, a);
    }
#endif
}
```

```cpp
#include <hip/hip_runtime.h>
#include <hip/hip_cooperative_groups.h>
#include <cstdio>
#include <cstdint>
namespace cg = cooperative_groups;

#ifndef MK_N_LAUNCHES
#define MK_N_LAUNCHES 1
#endif

#define LAS __attribute__((address_space(3)))
typedef unsigned short bf16_t;
typedef short bf16x8 __attribute__((ext_vector_type(8)));
typedef float f32x2 __attribute__((ext_vector_type(2)));
typedef float f32x4 __attribute__((ext_vector_type(4)));
typedef float f32x16 __attribute__((ext_vector_type(16)));
typedef unsigned u32x2 __attribute__((ext_vector_type(2)));
typedef unsigned u32x4 __attribute__((ext_vector_type(4)));
typedef __bf16 bf16x2_t __attribute__((ext_vector_type(2)));

constexpr int DM = 2048, SEQ = 8192, CTXL = 256, NTOK = SEQ + CTXL, INW = 7168;
constexpr int NH = 8, HD = 64, VD = 128, ATTW = 1024, CONVW = 1024, CONVK = 31;
constexpr float EPS = 1e-6f;
constexpr float LOG2E = 1.4426950408889634f;
constexpr float QSCALE = 0.125f * LOG2E;
constexpr float LAM_INIT = 0.2f;

constexpr size_t MiB = 1u << 20;
constexpr size_t WS_MOD = 0;
constexpr size_t WS_BAR = 49152;
constexpr size_t WS_P0CNT = 63488;
constexpr size_t WS_ZERO_BYTES = 65536;
constexpr size_t WS_TAB = 65536;
constexpr size_t WS_WT = 1 * MiB;
constexpr size_t WS_WO = 29 * MiB;
constexpr size_t WS_H = 40 * MiB;
constexpr size_t WS_Q = 74 * MiB;
constexpr size_t WS_K = 90 * MiB;
constexpr size_t WS_VT = 107 * MiB;
constexpr size_t WS_GA = 124 * MiB;
constexpr size_t WS_Y = 140 * MiB;
constexpr size_t WS_GC = 156 * MiB;
constexpr size_t WS_MIX = 172 * MiB;
constexpr size_t WS_END = 204 * MiB;

constexpr int LDS_BYTES = 147456;

__device__ __forceinline__ unsigned cvtpk(float lo, float hi) { f32x2 v = {lo, hi}; bf16x2_t b = __builtin_convertvector(v, bf16x2_t); return __builtin_bit_cast(unsigned, b); }
__device__ __forceinline__ float bf_lo(unsigned u) { return __builtin_bit_cast(float, u << 16); }
__device__ __forceinline__ float bf_hi(unsigned u) { return __builtin_bit_cast(float, u & 0xffff0000u); }
__device__ __forceinline__ float wave_sum(float v) {
#pragma unroll
    for (int o = 1; o < 64; o <<= 1) v += __shfl_xor(v, o);
    return v;
}
__device__ __forceinline__ float wave_max(float v) {
#pragma unroll
    for (int o = 1; o < 64; o <<= 1) v = fmaxf(v, __shfl_xor(v, o));
    return v;
}
__device__ __forceinline__ float silu_f(float v) { return v * __builtin_amdgcn_rcpf(1.0f + __builtin_amdgcn_exp2f(-v * LOG2E)); }
__device__ __forceinline__ float sigmoid_f(float v) { return __builtin_amdgcn_rcpf(1.0f + __builtin_amdgcn_exp2f(-v * LOG2E)); }
__device__ __forceinline__ float fadd_s(float a, float b) { float r; asm("v_add_f32_e32 %0, %1, %2" : "=v"(r) : "v"(a), "v"(b)); return r; }
__device__ __forceinline__ int perm5(int f5) { return 16 * ((f5 >> 2) & 1) + 4 * (f5 >> 3) + (f5 & 3); }

namespace pg8 {
constexpr int BM = 256, BK = 64, HALF = 128, HTB = HALF * BK * 2, STAGE_BYTES = 8 * HTB;
constexpr int GK = 2048;
__device__ __forceinline__ int lds_byte(int r, int c) { const int st = (r >> 4) * 2 + (c >> 5), rr = r & 15, cc = c & 31, ob = rr * 64 + cc * 2; return st * 1024 + (ob ^ (((ob >> 9) & 1) << 5)); }
__device__ __forceinline__ void stage_rc(int b, int& R, int& C) { const int st = b / 1024, sb = b % 1024, swz = sb ^ (((sb >> 9) & 1) << 5); R = (st >> 1) * 16 + swz / 64; C = (st & 1) * 32 + (swz % 64) / 2; }

struct Unit { const char* a; const char* b; int kind, pm, pn; };

template <class Epi, class Sched>
__device__ __forceinline__ void gemm_phase(LAS unsigned char* lds, const Sched& S, const Epi& E) {
    const int tid = threadIdx.x, wid = __builtin_amdgcn_readfirstlane(tid >> 6), lane = tid & 63, wr = wid >> 2, wc = wid & 3, fr = lane & 15, fq = lane >> 4;
    constexpr int K = GK, nt = K / BK;
    unsigned voffA[2];
#pragma unroll
    for (int i = 0; i < 2; ++i) { int R, C; stage_rc(tid * 16 + i * 8192, R, C); voffA[i] = (unsigned)(R * K + C) * 2u; }
    const size_t kstep = (size_t)(BK * 2);
    const size_t hstep = (size_t)HALF * K * 2;
    const unsigned ldsw = (unsigned)wid * 1024u;
    const int aoff = lds_byte(wr * 64 + fr, fq * 8), boff = lds_byte(wc * 32 + fr, fq * 8);
#define PG8_SA(b, h) (((b) * 2 + (h)) * HTB)
#define PG8_SB(b, h) ((4 + (b) * 2 + (h)) * HTB)
#define PG8_STAGE(bufoff, gbase) do { _Pragma("unroll") for (int _i = 0; _i < 2; ++_i) \
        __builtin_amdgcn_global_load_lds((const unsigned*)((const char*)(gbase) + voffA[_i]), (LAS unsigned*)(lds + (bufoff) + ldsw + _i * 8192), 16, 0, 0); } while (0)
#define PG8_LDA(dst, b, h) do { _Pragma("unroll") for (int m = 0; m < 4; ++m) _Pragma("unroll") for (int k = 0; k < 2; ++k) dst[m][k] = *(const LAS bf16x8*)(lds + PG8_SA(b, h) + aoff + m * 2048 + k * 1024); } while (0)
#define PG8_LDB(dst, b, h) do { _Pragma("unroll") for (int n = 0; n < 2; ++n) _Pragma("unroll") for (int k = 0; k < 2; ++k) dst[n][k] = *(const LAS bf16x8*)(lds + PG8_SB(b, h) + boff + n * 2048 + k * 1024); } while (0)
#define PG8_MMA(ai, bj, At, Bt) do { __builtin_amdgcn_s_setprio(1); _Pragma("unroll") for (int m = 0; m < 4; ++m) _Pragma("unroll") for (int n = 0; n < 2; ++n) _Pragma("unroll") for (int k = 0; k < 2; ++k) \
        acc[ai][bj][m][n] = __builtin_amdgcn_mfma_f32_16x16x32_bf16(Bt[n][k], At[m][k], acc[ai][bj][m][n], 0, 0, 0); __builtin_amdgcn_s_setprio(0); } while (0)
#define PG8_WAIT_V(n) asm volatile("s_waitcnt vmcnt(" #n ")" ::: "memory")
#define PG8_WAIT_L(n) asm volatile("s_waitcnt lgkmcnt(" #n ")" ::: "memory")
#define PG8_BAR __builtin_amdgcn_s_barrier()
#define PG8_SCHED __builtin_amdgcn_sched_barrier(0)
    Unit cur, nxt; int ui = 0;
    if (!S.next(0, cur)) return;
    f32x4 acc[2][2][4][2];
#pragma unroll
    for (int a = 0; a < 2; ++a)
#pragma unroll
        for (int b = 0; b < 2; ++b)
#pragma unroll
            for (int m = 0; m < 4; ++m)
#pragma unroll
                for (int n = 0; n < 2; ++n) acc[a][b][m][n] = (f32x4){0.f, 0.f, 0.f, 0.f};
    bf16x8 At[4][2], B0[2][2], B1[2][2];
    const char* cA = cur.a; const char* cB = cur.b;
    PG8_STAGE(PG8_SB(0, 0), cB); PG8_STAGE(PG8_SB(0, 1), cB + hstep); PG8_STAGE(PG8_SA(0, 0), cA); PG8_STAGE(PG8_SA(0, 1), cA + hstep);
    if (wr == 1) PG8_BAR;
    PG8_WAIT_V(2); PG8_BAR;
    PG8_STAGE(PG8_SB(1, 0), cB + kstep); PG8_STAGE(PG8_SA(1, 0), cA + kstep); PG8_STAGE(PG8_SB(1, 1), cB + hstep + kstep);
    PG8_WAIT_V(6); PG8_BAR;
    for (;;) {
        const bool has_next = S.next(ui + 1, nxt);
        const char* nA = has_next ? nxt.a : cA; const char* nB = has_next ? nxt.b : cB;
        for (int t = 0; t < nt; t += 2) {
            const bool last = (t == nt - 2);
            const char* a1 = cA + (size_t)(t + 1) * kstep;
            const char* a2 = last ? nA : cA + (size_t)(t + 2) * kstep; const char* b2 = last ? nB : cB + (size_t)(t + 2) * kstep;
            const char* a3 = a2 + kstep; const char* b3 = b2 + kstep;
            PG8_LDB(B0, 0, 0); PG8_LDB(B1, 0, 1); PG8_SCHED; PG8_LDA(At, 0, 0); PG8_STAGE(PG8_SA(1, 1), a1 + hstep);
            PG8_WAIT_V(8); PG8_WAIT_L(0); PG8_BAR; PG8_MMA(0, 0, At, B0); PG8_MMA(0, 1, At, B1); PG8_BAR; PG8_SCHED;
            PG8_LDA(At, 0, 1); PG8_STAGE(PG8_SB(0, 0), b2); PG8_STAGE(PG8_SB(0, 1), b2 + hstep); PG8_STAGE(PG8_SA(0, 0), a2);
            PG8_WAIT_V(8); PG8_WAIT_L(0); PG8_BAR; PG8_MMA(1, 0, At, B0); PG8_MMA(1, 1, At, B1); PG8_BAR; PG8_SCHED;
            PG8_LDB(B0, 1, 0); PG8_LDB(B1, 1, 1); PG8_SCHED; PG8_LDA(At, 1, 0); PG8_STAGE(PG8_SA(0, 1), a2 + hstep);
            PG8_WAIT_V(8); PG8_WAIT_L(0); PG8_BAR; PG8_MMA(0, 0, At, B0); PG8_MMA(0, 1, At, B1); PG8_BAR; PG8_SCHED;
            PG8_LDA(At, 1, 1); PG8_STAGE(PG8_SB(1, 0), b3); PG8_STAGE(PG8_SB(1, 1), b3 + hstep); PG8_STAGE(PG8_SA(1, 0), a3);
            PG8_WAIT_V(8); PG8_WAIT_L(0); PG8_BAR; PG8_MMA(1, 0, At, B0); PG8_MMA(1, 1, At, B1); PG8_BAR; PG8_SCHED;
        }
        if (wr == 0) PG8_BAR;
        E(acc, cur, wr, wc, fr, fq);
        if (!has_next) break;
#pragma unroll
        for (int a = 0; a < 2; ++a)
#pragma unroll
            for (int b = 0; b < 2; ++b)
#pragma unroll
                for (int m = 0; m < 4; ++m)
#pragma unroll
                    for (int n = 0; n < 2; ++n) acc[a][b][m][n] = (f32x4){0.f, 0.f, 0.f, 0.f};
        cur = nxt; cA = nA; cB = nB; ++ui;
        if (wr == 1) PG8_BAR;
    }
    PG8_WAIT_V(0);
    PG8_BAR;
#undef PG8_SA
#undef PG8_SB
#undef PG8_STAGE
#undef PG8_LDA
#undef PG8_LDB
#undef PG8_MMA
#undef PG8_WAIT_V
#undef PG8_WAIT_L
#undef PG8_BAR
#undef PG8_SCHED
}
}

struct Args { const float* in[20]; float* out; unsigned char* ws; int ph_lo, ph_hi; };
template <int OFF> __device__ __forceinline__ unsigned long long karg64() {
    unsigned long long v;
    asm volatile("s_load_dwordx2 %0, %1, %2\n\ts_waitcnt lgkmcnt(0)" : "=s"(v) : "s"(__builtin_amdgcn_kernarg_segment_ptr()), "n"(OFF) : "memory");
    return v;
}
#define GAS __attribute__((address_space(1)))
#define KIN(i) ((const float*)(GAS const float*)karg64<8 * (i)>())
#define KOUT ((float*)(GAS float*)karg64<160>())
#define KWS ((unsigned char*)(GAS unsigned char*)karg64<168>())
enum { I_X = 0, I_C, I_CTX, I_CCTX, I_WADA, I_BADA, I_NORMG, I_WIN, I_QG, I_KG, I_LQ1, I_LK1, I_LQ2, I_LK2, I_SUBG, I_CONVW, I_CONVB, I_LNG, I_LNB, I_WOUT };

struct SchedIn {
    const char* ws; int c, G, L0, L1;
    __device__ __forceinline__ bool next(int i, pg8::Unit& u) const {
        const int L = L0 + i * G + c; if (L >= L1) return false;
        constexpr size_t RB = (size_t)DM * 2;
        const char* H = ws + WS_H; const char* WT = ws + WS_WT;
        if (L < 768) {
            int wgid = (L % 8) * 96 + L / 8;
            const int gid = wgid / 192, rem = wgid % 192;
            const int pm = gid * 8 + (rem % 8), pn = rem / 8;
            u.a = H + (size_t)(256 + 256 * pm) * RB; u.b = WT + (size_t)(256 * pn) * RB; u.pm = pm; u.pn = pn;
            u.kind = (pn < 8) ? 0 : ((pn >= 12 && pn < 20) ? 2 : 1);
        } else if (L < 900) {
            const int idx = L - 768, pm = idx & 3, pn = idx >> 2;
            u.a = WT + (size_t)(6144 + 256 * pm) * RB; u.b = H + (size_t)(256 * pn) * RB; u.pm = pm; u.pn = pn; u.kind = 3;
        } else {
            const int pn = L - 900;
            u.a = H; u.b = WT + (size_t)(1024 + 256 * pn) * RB; u.pm = 0; u.pn = pn; u.kind = 4;
        }
        return true;
    }
};
struct SchedOut {
    const char* ws; int c, G;
    __device__ __forceinline__ bool next(int i, pg8::Unit& u) const {
        const int L = i * G + c; if (L >= 256) return false;
        constexpr size_t RB = (size_t)DM * 2;
        int wgid = (L % 8) * 32 + L / 8;
        const int gid = wgid / 64, rem = wgid % 64;
        const int pm = gid * 8 + (rem % 8), pn = rem / 8;
        u.a = ws + WS_MIX + (size_t)(256 * pm) * RB; u.b = ws + WS_WO + (size_t)(256 * pn) * RB; u.pm = pm; u.pn = pn; u.kind = 5;
        return true;
    }
};

struct EpiIn {
    __device__ __forceinline__ void operator()(const f32x4 (&acc)[2][2][4][2], const pg8::Unit& u, int wr, int wc, int fr, int fq) const {
        const int kind = u.kind;
        unsigned char* ws = KWS;
        if (kind == 0 || kind == 4) {
            const bool isq = (kind == 0) && (u.pn < 4);
            const float* gsrc = isq ? KIN(I_QG) : KIN(I_KG);
            const float osc = isq ? QSCALE : 1.0f;
            const f32x2* tab = (const f32x2*)(ws + WS_TAB);
            f32x4 g[2][2];
#pragma unroll
            for (int bj = 0; bj < 2; ++bj)
#pragma unroll
                for (int n = 0; n < 2; ++n) g[bj][n] = *(const f32x4*)(gsrc + 32 * bj + 16 * n + 4 * fq);
            bf16_t* dst = (bf16_t*)(ws + (isq ? WS_Q : WS_K));
            const int rowoff = (kind == 0 && !isq) ? CTXL : 0;
            const int G = 4 * (u.pn & 3) + wc;
#pragma unroll
            for (int ai = 0; ai < 2; ++ai) {
                const int rpos = 4 * u.pm + 2 * ai + wr;
                f32x4 cr0, cr1;
                if (kind == 0) { const f32x4* tp = (const f32x4*)(tab + rpos * 16 + 4 * fq); cr0 = tp[0]; cr1 = tp[1]; }
                else { cr0 = (f32x4){1.f, 0.f, 1.f, 0.f}; cr1 = cr0; }
#pragma unroll
                for (int m = 0; m < 4; ++m) {
                    const int t = 256 * u.pm + 128 * ai + 64 * wr + 16 * m + fr;
                    float ss = 0.f;
#pragma unroll
                    for (int bj = 0; bj < 2; ++bj)
#pragma unroll
                        for (int n = 0; n < 2; ++n) { const f32x4 v = acc[ai][bj][m][n]; ss += (v[0] * v[0] + v[1] * v[1]) + (v[2] * v[2] + v[3] * v[3]); }
                    ss += __shfl_xor(ss, 16); ss += __shfl_xor(ss, 32);
                    const float rstd = __builtin_amdgcn_rsqf(ss * (1.0f / 64.0f) + EPS) * osc;
                    f32x4 cc0, cc1;
                    if (kind == 0) { const f32x4* tp = (const f32x4*)(tab + (16 * m + fr) * 16 + 4 * fq); cc0 = tp[0]; cc1 = tp[1]; }
                    else { cc0 = (f32x4){1.f, 0.f, 1.f, 0.f}; cc1 = cc0; }
                    bf16_t* rowp = dst + (size_t)(rowoff + t) * 1024 + G * 64 + 8 * fq;
#pragma unroll
                    for (int bj = 0; bj < 2; ++bj) {
                        const f32x4 x1 = acc[ai][bj][m][0] * g[bj][0] * rstd, x2 = acc[ai][bj][m][1] * g[bj][1] * rstd;
                        const f32x4 ca = bj == 0 ? cr0 : cc0, cb = bj == 0 ? cr1 : cc1;
                        const float co[4] = {ca[0], ca[2], cb[0], cb[2]}, si[4] = {ca[1], ca[3], cb[1], cb[3]};
                        float o1[4], o2[4];
#pragma unroll
                        for (int e = 0; e < 4; ++e) { o1[e] = x1[e] * co[e] - x2[e] * si[e]; o2[e] = x2[e] * co[e] + x1[e] * si[e]; }
                        u32x4 w; w.x = cvtpk(o1[0], o1[1]); w.y = cvtpk(o1[2], o1[3]); w.z = cvtpk(o2[0], o2[1]); w.w = cvtpk(o2[2], o2[3]);
                        *(u32x4*)(rowp + 32 * bj) = w;
                    }
                }
            }
        } else if (kind == 1) {
            const bool isa = u.pn < 12; const int pnl = isa ? (u.pn - 8) : (u.pn - 20);
            bf16_t* dst = (bf16_t*)(ws + (isa ? WS_GA : WS_GC));
#pragma unroll
            for (int ai = 0; ai < 2; ++ai)
#pragma unroll
                for (int m = 0; m < 4; ++m) {
                    const int t = 256 * u.pm + 128 * ai + 64 * wr + 16 * m + fr;
                    bf16_t* rowp = dst + (size_t)t * 1024 + 256 * pnl + 32 * wc + 8 * fq;
#pragma unroll
                    for (int bj = 0; bj < 2; ++bj) {
                        const f32x4 v0 = acc[ai][bj][m][0], v1 = acc[ai][bj][m][1];
                        u32x4 w; w.x = cvtpk(silu_f(v0[0]), silu_f(v0[1])); w.y = cvtpk(silu_f(v0[2]), silu_f(v0[3]));
                        w.z = cvtpk(silu_f(v1[0]), silu_f(v1[1])); w.w = cvtpk(silu_f(v1[2]), silu_f(v1[3]));
                        *(u32x4*)(rowp + 128 * bj) = w;
                    }
                }
        } else if (kind == 2) {
            const int pnl = u.pn - 12;
            bf16_t* Y = (bf16_t*)(ws + WS_Y);
#pragma unroll
            for (int ai = 0; ai < 2; ++ai)
#pragma unroll
                for (int m = 0; m < 4; ++m) {
                    const int t = 256 * u.pm + 128 * ai + 64 * wr + 16 * m + fr;
                    bf16_t* rowp = Y + (size_t)t * 1024 + 128 * pnl + 32 * wc + 8 * fq;
                    const f32x4 a0 = acc[ai][0][m][0], a1 = acc[ai][0][m][1], g0 = acc[ai][1][m][0], g1 = acc[ai][1][m][1];
                    u32x4 w; w.x = cvtpk(a0[0] * sigmoid_f(g0[0]), a0[1] * sigmoid_f(g0[1])); w.y = cvtpk(a0[2] * sigmoid_f(g0[2]), a0[3] * sigmoid_f(g0[3]));
                    w.z = cvtpk(a1[0] * sigmoid_f(g1[0]), a1[1] * sigmoid_f(g1[1])); w.w = cvtpk(a1[2] * sigmoid_f(g1[2]), a1[3] * sigmoid_f(g1[3]));
                    *(u32x4*)rowp = w;
                }
        } else {
            const int sfq = (fq == 1) ? 2 : ((fq == 2) ? 1 : fq);
            bf16_t* VT = (bf16_t*)(ws + WS_VT);
#pragma unroll
            for (int ai = 0; ai < 2; ++ai)
#pragma unroll
                for (int m = 0; m < 4; ++m) {
                    const int f = 256 * u.pm + 128 * ai + 64 * wr + 16 * m + fr;
                    bf16_t* rowp = VT + (size_t)f * NTOK + 256 * u.pn + 32 * wc + 4 * sfq;
#pragma unroll
                    for (int bj = 0; bj < 2; ++bj)
#pragma unroll
                        for (int n = 0; n < 2; ++n) { const f32x4 v = acc[ai][bj][m][n]; u32x2 w; w.x = cvtpk(v[0], v[1]); w.y = cvtpk(v[2], v[3]); *(u32x2*)(rowp + 128 * bj + 16 * n) = w; }
                }
        }
    }
};
struct EpiOut {
    __device__ __forceinline__ void operator()(const f32x4 (&acc)[2][2][4][2], const pg8::Unit& u, int wr, int wc, int fr, int fq) const {
        const float* gate = (const float*)(KWS + WS_MOD) + 4096; const float* gb = KIN(I_BADA) + 4096;
        const float* x = KIN(I_X); float* out = KOUT;
        const int col0 = 256 * u.pn + 32 * wc + 4 * fq;
        f32x4 gv[2][2];
#pragma unroll
        for (int bj = 0; bj < 2; ++bj)
#pragma unroll
            for (int n = 0; n < 2; ++n) gv[bj][n] = *(const f32x4*)(gate + col0 + 128 * bj + 16 * n) + *(const f32x4*)(gb + col0 + 128 * bj + 16 * n);
#pragma unroll
        for (int ai = 0; ai < 2; ++ai)
#pragma unroll
            for (int mh = 0; mh < 2; ++mh) {
                f32x4 xv[2][2][2];
#pragma unroll
                for (int mm = 0; mm < 2; ++mm) {
                    const size_t off = (size_t)(256 * u.pm + 128 * ai + 64 * wr + 16 * (2 * mh + mm) + fr) * DM + col0;
#pragma unroll
                    for (int bj = 0; bj < 2; ++bj)
#pragma unroll
                        for (int n = 0; n < 2; ++n) xv[mm][bj][n] = *(const f32x4*)(x + off + 128 * bj + 16 * n);
                }
#pragma unroll
                for (int mm = 0; mm < 2; ++mm) {
                    const size_t off = (size_t)(256 * u.pm + 128 * ai + 64 * wr + 16 * (2 * mh + mm) + fr) * DM + col0;
#pragma unroll
                    for (int bj = 0; bj < 2; ++bj)
#pragma unroll
                        for (int n = 0; n < 2; ++n) *(f32x4*)(out + off + 128 * bj + 16 * n) = xv[mm][bj][n] + gv[bj][n] * acc[ai][bj][2 * mh + mm][n];
                }
            }
    }
};

__device__ __forceinline__ int win_dest_row(int s) {
    if (s < 2048) { const int base = s & ~1023, ss = s & 1023, G = ss >> 6, d = ss & 63; return base + 256 * (G >> 2) + 128 * (d >> 5) + 32 * (G & 3) + (d & 31); }
    if (s < 3072) return 6144 + (s - 2048);
    if (s < 4096) { const int f = s - 3072; return 2048 + (f & ~31) + perm5(f & 31); }
    if (s < 6144) { const int isg = s >= 5120 ? 1 : 0, ch = s - 4096 - 1024 * isg; return 3072 + 256 * (ch >> 7) + 128 * isg + (ch & 96) + perm5(ch & 31); }
    const int f = s - 6144; return 5120 + (f & ~31) + perm5(f & 31);
}
__device__ __forceinline__ void transpose_item(const float* W, int N, bf16_t* WT, int k0, int n0, bool is_in, LAS float* scr, int lane) {
    const int lr = lane >> 4, lc = (lane & 15) * 4;
    f32x4 v[16];
#pragma unroll
    for (int i = 0; i < 16; ++i) v[i] = *(const f32x4*)(W + (size_t)(k0 + 4 * i + lr) * N + n0 + lc);
#pragma unroll
    for (int i = 0; i < 16; ++i) { LAS float* d = scr + (4 * i + lr) * 65 + lc; d[0] = v[i][0]; d[1] = v[i][1]; d[2] = v[i][2]; d[3] = v[i][3]; }
    asm volatile("s_waitcnt lgkmcnt(0)" ::: "memory");
    const int c = lane & 7;
#pragma unroll
    for (int j = 0; j < 8; ++j) {
        const int n = (lane >> 3) + 8 * j; const LAS float* s = scr + (8 * c) * 65 + n;
        u32x4 o; o.x = cvtpk(s[0 * 65], s[1 * 65]); o.y = cvtpk(s[2 * 65], s[3 * 65]); o.z = cvtpk(s[4 * 65], s[5 * 65]); o.w = cvtpk(s[6 * 65], s[7 * 65]);
        const int dr = is_in ? win_dest_row(n0 + n) : (n0 + n);
        *(u32x4*)(WT + (size_t)dr * DM + k0 + 8 * c) = o;
    }
    asm volatile("s_waitcnt lgkmcnt(0)" ::: "memory");
}

__device__ __forceinline__ void phase0(LAS unsigned char* lds, int bx, int G, int lane, int wave) {
    unsigned char* ws = KWS;
    const float* w_ada = KIN(I_WADA); const float* cv = KIN(I_C); const float* ccv = KIN(I_CCTX);
    float* modx = (float*)(ws + WS_MOD);
    LAS float* red = (LAS float*)lds;
    for (int wi = bx; wi < 256; wi += G) {
        const int cc = wi & 31, kb = ((wi >> 5) * 8 + wave) * 32, cb = cc * 192 + lane * 4;
        f32x4 ax = {0.f, 0.f, 0.f, 0.f}, ac = {0.f, 0.f, 0.f, 0.f};
        if (lane < 48) {
#pragma unroll
            for (int k = 0; k < 32; ++k) {
                const f32x4 w = __builtin_nontemporal_load((const f32x4*)(w_ada + (size_t)(kb + k) * 6144 + cb));
                const float sx = silu_f(cv[kb + k]), sc = silu_f(ccv[kb + k]);
                ax += w * sx; ac += w * sc;
            }
            *(LAS f32x4*)(red + (wave * 2 + 0) * 192 + lane * 4) = ax;
            *(LAS f32x4*)(red + (wave * 2 + 1) * 192 + lane * 4) = ac;
        }
        __syncthreads();
        {
            const int t = threadIdx.x;
            if (t < 384) {
                const int vec = t / 192, col = t - vec * 192;
                float s = 0.f;
#pragma unroll
                for (int w = 0; w < 8; ++w) s += red[(w * 2 + vec) * 192 + col];
                unsafeAtomicAdd(modx + vec * 6144 + cc * 192 + col, s);
            }
        }
        __syncthreads();
    }
    asm volatile("s_waitcnt vmcnt(0)" ::: "memory");
    __syncthreads();
    if (threadIdx.x == 0) __hip_atomic_fetch_add((unsigned*)(ws + WS_P0CNT), 1u, __ATOMIC_RELAXED, __HIP_MEMORY_SCOPE_AGENT);
    {
        const int gt = (bx * 8 + wave) * 64 + lane;
        if (gt < 2048) {
            const int p = gt >> 4, f = gt & 15;
            const float inv = exp2f(-(float)f * (13.287712379549449f / 16.0f));
            const float ang = (float)p * inv;
            float rev = ang * 0.15915494309189535f; rev -= floorf(rev);
            ((f32x2*)(ws + WS_TAB))[gt] = (f32x2){__builtin_amdgcn_cosf(rev), __builtin_amdgcn_sinf(rev)};
        }
    }
}

__device__ __forceinline__ void phase1(LAS unsigned char* lds, int gw, int NGW, int lane, int wave) {
    unsigned char* ws = KWS;
    {
        LAS float* scr = (LAS float*)(lds + wave * 16640);
        const float* w_in = KIN(I_WIN); const float* w_out = KIN(I_WOUT);
        bf16_t* WT = (bf16_t*)(ws + WS_WT); bf16_t* WO = (bf16_t*)(ws + WS_WO);
        constexpr int NB_IN = INW / 64, NB_OUT = DM / 64, I_IN = 32 * NB_IN, I_OUT = 32 * NB_OUT;
        const int n_items = (NGW == 2048) ? I_IN : I_IN + I_OUT;
        for (int it = (NGW - 1 - gw); it < n_items; it += NGW) {
            if (it < I_IN) { const int kb = it / NB_IN, nb = it % NB_IN; transpose_item(w_in, INW, WT, kb * 64, nb * 64, true, scr, lane); }
            else { const int r2 = it - I_IN, kb = r2 / NB_OUT, nb = r2 % NB_OUT; transpose_item(w_out, DM, WO, kb * 64, nb * 64, false, scr, lane); }
        }
    }
    if (threadIdx.x == 0) {
        unsigned* cnt = (unsigned*)(ws + WS_P0CNT); const unsigned want = gridDim.x; unsigned spins = 0;
        while (__hip_atomic_load(cnt, __ATOMIC_RELAXED, __HIP_MEMORY_SCOPE_AGENT) < want) { __builtin_amdgcn_s_sleep(2); if (++spins > (1u << 20)) break; }
    }
    __syncthreads();
    const float* x = KIN(I_X); const float* ctx = KIN(I_CTX);
    {
        const float* b_ada = KIN(I_BADA); const float* norm_g = KIN(I_NORMG);
        float* modx = (float*)(ws + WS_MOD); float* modc = modx + 6144;
        const int col = threadIdx.x * 4;
        const f32x4 g = *(const f32x4*)(norm_g + col), bsh = *(const f32x4*)(b_ada + col), bsc = *(const f32x4*)(b_ada + 2048 + col);
        f32x4 sx, hx, sc, hc;
#pragma unroll
        for (int e = 0; e < 4; ++e) {
            sx[e] = __hip_atomic_load(modx + 2048 + col + e, __ATOMIC_RELAXED, __HIP_MEMORY_SCOPE_AGENT); hx[e] = __hip_atomic_load(modx + col + e, __ATOMIC_RELAXED, __HIP_MEMORY_SCOPE_AGENT);
            sc[e] = __hip_atomic_load(modc + 2048 + col + e, __ATOMIC_RELAXED, __HIP_MEMORY_SCOPE_AGENT); hc[e] = __hip_atomic_load(modc + col + e, __ATOMIC_RELAXED, __HIP_MEMORY_SCOPE_AGENT);
        }
        *(LAS f32x4*)(lds + 0 * 8192 + col * 4) = g * (1.0f + sx + bsc);
        *(LAS f32x4*)(lds + 1 * 8192 + col * 4) = hx + bsh;
        *(LAS f32x4*)(lds + 2 * 8192 + col * 4) = g * (1.0f + sc + bsc);
        *(LAS f32x4*)(lds + 3 * 8192 + col * 4) = hc + bsh;
    }
    __syncthreads();
    bf16_t* H = (bf16_t*)(ws + WS_H);
    f32x4 cur[8], nxt[8];
    int r = gw;
    if (r < NTOK) {
        const float* src = (r < CTXL) ? ctx + (size_t)r * DM : x + (size_t)(r - CTXL) * DM;
#pragma unroll
        for (int j = 0; j < 8; ++j) cur[j] = *(const f32x4*)(src + (lane + 64 * j) * 4);
    }
    for (; r < NTOK; r += NGW) {
        const int rn = r + NGW;
        if (rn < NTOK) {
            const float* src = (rn < CTXL) ? ctx + (size_t)rn * DM : x + (size_t)(rn - CTXL) * DM;
#pragma unroll
            for (int j = 0; j < 8; ++j) nxt[j] = *(const f32x4*)(src + (lane + 64 * j) * 4);
        }
        float ss = 0.f;
#pragma unroll
        for (int j = 0; j < 8; ++j) ss += (cur[j][0] * cur[j][0] + cur[j][1] * cur[j][1]) + (cur[j][2] * cur[j][2] + cur[j][3] * cur[j][3]);
        const float rstd = __builtin_amdgcn_rsqf(wave_sum(ss) * (1.0f / DM) + EPS);
        const int sel = (r < CTXL) ? 2 * 8192 : 0;
        bf16_t* dst = H + (size_t)r * DM;
#pragma unroll
        for (int j = 0; j < 8; ++j) {
            const int col = (lane + 64 * j) * 4;
            const f32x4 ge = *(const LAS f32x4*)(lds + sel + col * 4), sh = *(const LAS f32x4*)(lds + sel + 8192 + col * 4);
            const f32x4 o = cur[j] * rstd * ge + sh;
            u32x2 w; w.x = cvtpk(o[0], o[1]); w.y = cvtpk(o[2], o[3]);
            *(u32x2*)(dst + col) = w;
        }
#pragma unroll
        for (int j = 0; j < 8; ++j) cur[j] = nxt[j];
    }
    __syncthreads();
}

constexpr int AT_KBYTES = 16384, AT_VBYTES = 16384, AT_BUF = AT_KBYTES + AT_VBYTES;
constexpr int AT_XOFF = 0;
constexpr int AT_NT = NTOK / 64;
static_assert(3 * AT_BUF <= LDS_BYTES - 64, "attention ring");

__device__ __forceinline__ void attn_unit(unsigned char* ws, const float* sub_g, LAS unsigned char* lds, int h, int qb, float negM, float lam) {
    const int tid = threadIdx.x, lane = tid & 63, r32 = lane & 31, hi = lane >> 5;
    const int wid = __builtin_amdgcn_readfirstlane(tid >> 6), map = wid >> 2, wq = wid & 3;
    const int qrow0 = qb * 128 + 32 * wq;
    const bf16_t* Qp = (const bf16_t*)(ws + WS_Q); const bf16_t* Kp = (const bf16_t*)(ws + WS_K); const bf16_t* VTp = (const bf16_t*)(ws + WS_VT);
    bf16x8 qf[4];
    {
        const bf16_t* qp = Qp + (size_t)(qrow0 + r32) * 1024 + (h * 2 + map) * 64 + 8 * hi;
#pragma unroll
        for (int d0 = 0; d0 < 4; ++d0) qf[d0] = *(const bf16x8*)(qp + 16 * d0);
    }
    const bf16_t* kg[2]; const bf16_t* vg[2];
#pragma unroll
    for (int i = 0; i < 2; ++i) {
        const int g = 2 * wid + i;
        const int kr = 4 * g + (lane >> 4), kc = (lane & 15) ^ (kr & 15);
        kg[i] = Kp + (size_t)kr * 1024 + h * 128 + kc * 8;
        const int vr = 8 * g + (lane >> 3), vc = (lane & 7) ^ ((vr >> 1) & 7);
        vg[i] = VTp + (size_t)(h * 128 + vr) * NTOK + vc * 8;
    }
    const unsigned dmaoff = (unsigned)wid * 2048u;
#define AT_DMA(B) do { _Pragma("unroll") for (int i_ = 0; i_ < 2; ++i_) { \
        __builtin_amdgcn_global_load_lds((const unsigned*)kg[i_], (LAS unsigned*)(lds + (B) + dmaoff + i_ * 1024), 16, 0, 0); \
        __builtin_amdgcn_global_load_lds((const unsigned*)vg[i_], (LAS unsigned*)(lds + (B) + AT_KBYTES + dmaoff + i_ * 1024), 16, 0, 0); } } while (0)
#define AT_ADV() do { kg[0] += 64 * 1024; kg[1] += 64 * 1024; vg[0] += 64; vg[1] += 64; } while (0)
    int kad[4], vad[4];
#pragma unroll
    for (int d0 = 0; d0 < 4; ++d0) kad[d0] = r32 * 256 + (((map * 8 + 2 * d0 + hi) ^ (r32 & 15)) << 4);
#pragma unroll
    for (int j = 0; j < 4; ++j) vad[j] = AT_KBYTES + r32 * 128 + (((2 * j + hi) ^ ((r32 >> 1) & 7)) << 4);
#define SB() __builtin_amdgcn_sched_barrier(0)
#define KFR(B, d0, kh) (*(const LAS bf16x8*)(lds + (B) + kad[d0] + (kh) * 8192))
#define VFR(B, j, b) (*(const LAS bf16x8*)(lds + (B) + vad[j] + (b) * 4096))
    f32x16 o[4];
#pragma unroll
    for (int b = 0; b < 4; ++b)
#pragma unroll
        for (int r = 0; r < 16; ++r) o[b][r] = 0.f;
    f32x16 negm;
#pragma unroll
    for (int r = 0; r < 16; ++r) negm[r] = negM;
    float l0 = 0.f, l1 = 0.f;
    AT_DMA(0); AT_ADV();
    asm volatile("s_waitcnt vmcnt(0)" ::: "memory");
    __builtin_amdgcn_s_barrier();
    AT_DMA(AT_BUF); AT_ADV();
    f32x16 pa, pb;
    {
        f32x16 s0 = negm, s1 = negm;
#pragma unroll
        for (int d0 = 0; d0 < 4; ++d0) { s0 = __builtin_amdgcn_mfma_f32_32x32x16_bf16(KFR(0, d0, 0), qf[d0], s0, 0, 0, 0); s1 = __builtin_amdgcn_mfma_f32_32x32x16_bf16(KFR(0, d0, 1), qf[d0], s1, 0, 0, 0); }
#pragma unroll
        for (int r = 0; r < 16; ++r) { pa[r] = __builtin_amdgcn_exp2f(s0[r]); pb[r] = __builtin_amdgcn_exp2f(s1[r]); }
    }
    asm volatile("s_waitcnt vmcnt(0) lgkmcnt(0)" ::: "memory");
    __builtin_amdgcn_s_barrier();
    int bV = 0, bK = AT_BUF, bW = 2 * AT_BUF;
    u32x4 pw[4];
    for (int t = 1; t < AT_NT; ++t) {
        AT_DMA(bW);
        if (t + 2 < AT_NT) AT_ADV();
        SB();
#define FADDR(i) (((i) < 8) ? (bK + kad[(i) >> 1] + ((i) & 1) * 8192) : (bV + vad[((i) - 8) >> 2] + (((i) - 8) & 3) * 4096))
#define FLOAD(i) (*(const LAS bf16x8*)(lds + FADDR(i)))
#define ADD4(P, base) do { l0 = fadd_s(l0, P[base]); l1 = fadd_s(l1, P[base + 1]); l0 = fadd_s(l0, P[base + 2]); l1 = fadd_s(l1, P[base + 3]); } while (0)
#define EXP2(S, P, base) do { P[base] = __builtin_amdgcn_exp2f(S[base]); P[base + 1] = __builtin_amdgcn_exp2f(S[base + 1]); } while (0)
        f32x16 s0, s1;
        bf16x8 F0 = FLOAD(0), F1 = FLOAD(1), F2;
        SB();
        F2 = FLOAD(2); s0 = __builtin_amdgcn_mfma_f32_32x32x16_bf16(F0, qf[0], negm, 0, 0, 0); ADD4(pa, 0); pw[0][0] = cvtpk(pa[0], pa[1]); SB();
        F0 = FLOAD(3); s1 = __builtin_amdgcn_mfma_f32_32x32x16_bf16(F1, qf[0], negm, 0, 0, 0); ADD4(pa, 4); pw[0][1] = cvtpk(pa[2], pa[3]); SB();
        F1 = FLOAD(4); s0 = __builtin_amdgcn_mfma_f32_32x32x16_bf16(F2, qf[1], s0, 0, 0, 0); ADD4(pa, 8); pw[0][2] = cvtpk(pa[4], pa[5]); SB();
        F2 = FLOAD(5); s1 = __builtin_amdgcn_mfma_f32_32x32x16_bf16(F0, qf[1], s1, 0, 0, 0); ADD4(pa, 12); pw[0][3] = cvtpk(pa[6], pa[7]); SB();
        F0 = FLOAD(6); s0 = __builtin_amdgcn_mfma_f32_32x32x16_bf16(F1, qf[2], s0, 0, 0, 0); ADD4(pb, 0); pw[1][0] = cvtpk(pa[8], pa[9]); SB();
        F1 = FLOAD(7); s1 = __builtin_amdgcn_mfma_f32_32x32x16_bf16(F2, qf[2], s1, 0, 0, 0); ADD4(pb, 4); pw[1][1] = cvtpk(pa[10], pa[11]); SB();
        F2 = FLOAD(8); s0 = __builtin_amdgcn_mfma_f32_32x32x16_bf16(F0, qf[3], s0, 0, 0, 0); ADD4(pb, 8); pw[1][2] = cvtpk(pa[12], pa[13]); SB();
        F0 = FLOAD(9); s1 = __builtin_amdgcn_mfma_f32_32x32x16_bf16(F1, qf[3], s1, 0, 0, 0); ADD4(pb, 12); pw[1][3] = cvtpk(pa[14], pa[15]); SB();
        F1 = FLOAD(10); o[0] = __builtin_amdgcn_mfma_f32_32x32x16_bf16(F2, __builtin_bit_cast(bf16x8, pw[0]), o[0], 0, 0, 0); pw[2][0] = cvtpk(pb[0], pb[1]); EXP2(s0, pa, 0); SB();
        F2 = FLOAD(11); o[1] = __builtin_amdgcn_mfma_f32_32x32x16_bf16(F0, __builtin_bit_cast(bf16x8, pw[0]), o[1], 0, 0, 0); pw[2][1] = cvtpk(pb[2], pb[3]); EXP2(s0, pa, 2); SB();
        F0 = FLOAD(12); o[2] = __builtin_amdgcn_mfma_f32_32x32x16_bf16(F1, __builtin_bit_cast(bf16x8, pw[0]), o[2], 0, 0, 0); pw[2][2] = cvtpk(pb[4], pb[5]); EXP2(s0, pa, 4); SB();
        F1 = FLOAD(13); o[3] = __builtin_amdgcn_mfma_f32_32x32x16_bf16(F2, __builtin_bit_cast(bf16x8, pw[0]), o[3], 0, 0, 0); pw[2][3] = cvtpk(pb[6], pb[7]); EXP2(s0, pa, 6); SB();
        F2 = FLOAD(14); o[0] = __builtin_amdgcn_mfma_f32_32x32x16_bf16(F0, __builtin_bit_cast(bf16x8, pw[1]), o[0], 0, 0, 0); pw[3][0] = cvtpk(pb[8], pb[9]); EXP2(s0, pa, 8); SB();
        F0 = FLOAD(15); o[1] = __builtin_amdgcn_mfma_f32_32x32x16_bf16(F1, __builtin_bit_cast(bf16x8, pw[1]), o[1], 0, 0, 0); pw[3][1] = cvtpk(pb[10], pb[11]); EXP2(s0, pa, 10); SB();
        F1 = FLOAD(16); o[2] = __builtin_amdgcn_mfma_f32_32x32x16_bf16(F2, __builtin_bit_cast(bf16x8, pw[1]), o[2], 0, 0, 0); pw[3][2] = cvtpk(pb[12], pb[13]); EXP2(s0, pa, 12); SB();
        F2 = FLOAD(17); o[3] = __builtin_amdgcn_mfma_f32_32x32x16_bf16(F0, __builtin_bit_cast(bf16x8, pw[1]), o[3], 0, 0, 0); pw[3][3] = cvtpk(pb[14], pb[15]); EXP2(s0, pa, 14); SB();
        F0 = FLOAD(18); o[0] = __builtin_amdgcn_mfma_f32_32x32x16_bf16(F1, __builtin_bit_cast(bf16x8, pw[2]), o[0], 0, 0, 0); EXP2(s1, pb, 0); SB();
        F1 = FLOAD(19); o[1] = __builtin_amdgcn_mfma_f32_32x32x16_bf16(F2, __builtin_bit_cast(bf16x8, pw[2]), o[1], 0, 0, 0); EXP2(s1, pb, 2); SB();
        F2 = FLOAD(20); o[2] = __builtin_amdgcn_mfma_f32_32x32x16_bf16(F0, __builtin_bit_cast(bf16x8, pw[2]), o[2], 0, 0, 0); EXP2(s1, pb, 4); SB();
        F0 = FLOAD(21); o[3] = __builtin_amdgcn_mfma_f32_32x32x16_bf16(F1, __builtin_bit_cast(bf16x8, pw[2]), o[3], 0, 0, 0); EXP2(s1, pb, 6); SB();
        F1 = FLOAD(22); o[0] = __builtin_amdgcn_mfma_f32_32x32x16_bf16(F2, __builtin_bit_cast(bf16x8, pw[3]), o[0], 0, 0, 0); EXP2(s1, pb, 8); SB();
        F2 = FLOAD(23); o[1] = __builtin_amdgcn_mfma_f32_32x32x16_bf16(F0, __builtin_bit_cast(bf16x8, pw[3]), o[1], 0, 0, 0); EXP2(s1, pb, 10); SB();
        o[2] = __builtin_amdgcn_mfma_f32_32x32x16_bf16(F1, __builtin_bit_cast(bf16x8, pw[3]), o[2], 0, 0, 0); EXP2(s1, pb, 12); SB();
        o[3] = __builtin_amdgcn_mfma_f32_32x32x16_bf16(F2, __builtin_bit_cast(bf16x8, pw[3]), o[3], 0, 0, 0); EXP2(s1, pb, 14); SB();
#undef ADD4
#undef EXP2
#undef FADDR
#undef FLOAD
        asm volatile("s_waitcnt vmcnt(0) lgkmcnt(0)" ::: "memory");
        __builtin_amdgcn_s_barrier();
        const int tmp = bV; bV = bK; bK = bW; bW = tmp;
    }
    {
        float a0 = 0.f, a1 = 0.f;
#pragma unroll
        for (int r = 0; r < 16; ++r) { a0 += pa[r]; a1 += pb[r]; }
        l0 += a0; l1 += a1;
        pw[0] = (u32x4){cvtpk(pa[0], pa[1]), cvtpk(pa[2], pa[3]), cvtpk(pa[4], pa[5]), cvtpk(pa[6], pa[7])};
        pw[1] = (u32x4){cvtpk(pa[8], pa[9]), cvtpk(pa[10], pa[11]), cvtpk(pa[12], pa[13]), cvtpk(pa[14], pa[15])};
        pw[2] = (u32x4){cvtpk(pb[0], pb[1]), cvtpk(pb[2], pb[3]), cvtpk(pb[4], pb[5]), cvtpk(pb[6], pb[7])};
        pw[3] = (u32x4){cvtpk(pb[8], pb[9]), cvtpk(pb[10], pb[11]), cvtpk(pb[12], pb[13]), cvtpk(pb[14], pb[15])};
#pragma unroll
        for (int j = 0; j < 4; ++j)
#pragma unroll
            for (int b = 0; b < 4; ++b) o[b] = __builtin_amdgcn_mfma_f32_32x32x16_bf16(VFR(bV, j, b), __builtin_bit_cast(bf16x8, pw[j]), o[b], 0, 0, 0);
    }
    float l = l0 + l1;
#undef AT_DMA
#undef AT_ADV
#undef SB
#undef KFR
#undef VFR
    asm volatile("s_waitcnt vmcnt(0) lgkmcnt(0)" ::: "memory");
    __builtin_amdgcn_s_barrier();
    l += __shfl_xor(l, 32);
    const float inv = 1.0f / l;
    LAS float* xw = (LAS float*)(lds + AT_XOFF + wq * 16384);
    if (map == 1) {
        const float f = inv * lam;
#pragma unroll
        for (int b = 0; b < 4; ++b)
#pragma unroll
            for (int r = 0; r < 16; ++r) xw[(b * 16 + r) * 64 + lane] = o[b][r] * f;
    }
    __syncthreads();
    if (map == 0) {
        float ss = 0.f;
#pragma unroll
        for (int b = 0; b < 4; ++b)
#pragma unroll
            for (int r = 0; r < 16; ++r) { const float v = o[b][r] * inv - xw[(b * 16 + r) * 64 + lane]; o[b][r] = v; ss += v * v; }
        ss += __shfl_xor(ss, 32);
        const float rs = __builtin_amdgcn_rsqf(ss * (1.0f / VD) + EPS) * (1.0f - LAM_INIT);
        LAS unsigned char* stg = (LAS unsigned char*)xw;
#pragma unroll
        for (int b = 0; b < 4; ++b)
#pragma unroll
            for (int r4 = 0; r4 < 4; ++r4) {
                const int dv = 32 * b + 8 * r4 + 4 * hi;
                const f32x4 sg = *(const f32x4*)(sub_g + dv);
                u32x2 w; w.x = cvtpk(o[b][4 * r4 + 0] * rs * sg[0], o[b][4 * r4 + 1] * rs * sg[1]); w.y = cvtpk(o[b][4 * r4 + 2] * rs * sg[2], o[b][4 * r4 + 3] * rs * sg[3]);
                *(LAS u32x2*)(stg + r32 * 272 + dv * 2) = w;
            }
        asm volatile("s_waitcnt lgkmcnt(0)" ::: "memory");
        const bf16_t* GA = (const bf16_t*)(ws + WS_GA); bf16_t* MIX = (bf16_t*)(ws + WS_MIX);
        u32x4 gvs[8];
#pragma unroll
        for (int i = 0; i < 8; ++i) gvs[i] = *(const u32x4*)(GA + (size_t)(qrow0 + (lane >> 4) + 4 * i) * 1024 + h * 128 + (lane & 15) * 8);
#pragma unroll
        for (int i = 0; i < 8; ++i) {
            const int q = (lane >> 4) + 4 * i, ch = lane & 15;
            const u32x4 ov = *(const LAS u32x4*)(stg + q * 272 + ch * 16);
            const size_t tok = (size_t)(qrow0 + q);
            const u32x4 gv = gvs[i];
            u32x4 w;
            w.x = cvtpk(bf_lo(ov.x) * bf_lo(gv.x), bf_hi(ov.x) * bf_hi(gv.x)); w.y = cvtpk(bf_lo(ov.y) * bf_lo(gv.y), bf_hi(ov.y) * bf_hi(gv.y));
            w.z = cvtpk(bf_lo(ov.z) * bf_lo(gv.z), bf_hi(ov.z) * bf_hi(gv.z)); w.w = cvtpk(bf_lo(ov.w) * bf_lo(gv.w), bf_hi(ov.w) * bf_hi(gv.w));
            *(u32x4*)(MIX + tok * DM + h * 128 + ch * 8) = w;
        }
    }
    __syncthreads();
}

__device__ __forceinline__ void conv_unit(unsigned char* ws, LAS unsigned char* lds, int t0) {
    const int tid = threadIdx.x, lane = tid & 63, wid = tid >> 6, c0 = 2 * tid;
    const float* conv_w = KIN(I_CONVW); const float* conv_b = KIN(I_CONVB);
    const bf16_t* Y = (const bf16_t*)(ws + WS_Y);
    float y0[62], y1[62];
#pragma unroll
    for (int r = 0; r < 62; ++r) {
        const int row = t0 - 15 + r;
        unsigned yv = 0u;
        if (row >= 0 && row < SEQ) yv = *(const unsigned*)(Y + (size_t)row * CONVW + c0);
        y0[r] = bf_lo(yv); y1[r] = bf_hi(yv);
    }
    const f32x2 bias = *(const f32x2*)(conv_b + c0);
    float a0[32], a1[32];
#pragma unroll
    for (int t = 0; t < 32; ++t) { a0[t] = bias[0]; a1[t] = bias[1]; }
#pragma unroll
    for (int j = 0; j < CONVK; ++j) {
        const f32x2 w = *(const f32x2*)(conv_w + j * CONVW + c0);
#pragma unroll
        for (int t = 0; t < 32; ++t) { a0[t] += w[0] * y0[t + j]; a1[t] += w[1] * y1[t + j]; }
    }
    const bf16_t* GC = (const bf16_t*)(ws + WS_GC);
    unsigned gcv[32];
#pragma unroll
    for (int t = 0; t < 32; ++t) gcv[t] = *(const unsigned*)(GC + (size_t)(t0 + t) * CONVW + c0);
    float v[64];
#pragma unroll
    for (int t = 0; t < 32; ++t) { v[t] = a0[t] + a1[t]; v[32 + t] = a0[t] * a0[t] + a1[t] * a1[t]; }
#pragma unroll
    for (int h = 32; h >= 1; h >>= 1) {
        const bool up = (lane & h) != 0;
#pragma unroll
        for (int i = 0; i < h; ++i) {
            const float send = up ? v[i] : v[i + h], keep = up ? v[i + h] : v[i];
            v[i] = keep + __shfl_xor(send, h);
        }
    }
    LAS float* red = (LAS float*)lds;
    LAS float* stat = red + 512;
    red[wid * 64 + lane] = v[0];
    __syncthreads();
    if (tid < 32) {
        float s1 = 0.f, s2 = 0.f;
#pragma unroll
        for (int w = 0; w < 8; ++w) { s1 += red[w * 64 + tid]; s2 += red[w * 64 + 32 + tid]; }
        const float mean = s1 * (1.0f / CONVW), var = fmaxf(s2 * (1.0f / CONVW) - mean * mean, 0.f);
        stat[tid * 2] = mean; stat[tid * 2 + 1] = __builtin_amdgcn_rsqf(var + EPS);
    }
    __syncthreads();
    const float* ln_g = KIN(I_LNG); const float* ln_b = KIN(I_LNB);
    bf16_t* MIX = (bf16_t*)(ws + WS_MIX);
    const f32x2 lg = *(const f32x2*)(ln_g + c0), lb = *(const f32x2*)(ln_b + c0);
#pragma unroll
    for (int t = 0; t < 32; ++t) {
        const float mean = stat[t * 2], rstd = stat[t * 2 + 1];
        const float v0 = (a0[t] - mean) * rstd * lg[0] + lb[0], v1 = (a1[t] - mean) * rstd * lg[1] + lb[1];
        const unsigned gc = gcv[t];
        *(unsigned*)(MIX + (size_t)(t0 + t) * DM + ATTW + c0) = cvtpk(silu_f(v0) * bf_lo(gc), silu_f(v1) * bf_hi(gc));
    }
    __syncthreads();
}

#define XB_TMO      128
#define XB_XCNT(j)  (256  + 64 * (j))
#define XB_XSUB(j)  (1280 + 64 * (j))
#define XB_XGEN(j)  (2304 + 64 * (j))
#define XB_TOP      3328
#define XB_TOPGEN   3392
#define XCD_BAR_WORDS 3456
#define XB_SPIN_CAP (1u << 18)
__device__ __forceinline__ unsigned xb_ld(unsigned* p)              { return __hip_atomic_load(p, __ATOMIC_RELAXED, __HIP_MEMORY_SCOPE_AGENT); }
__device__ __forceinline__ unsigned xb_add(unsigned* p, unsigned v) { return __hip_atomic_fetch_add(p, v, __ATOMIC_RELAXED, __HIP_MEMORY_SCOPE_AGENT); }
__device__ __forceinline__ unsigned xb_xcc_id() { return (unsigned)__builtin_amdgcn_s_getreg((3 << 11) | 20) & 0xFu; }
#define XB_SPIN(cond, bar) do { unsigned _sp = 0; while (cond) { __builtin_amdgcn_s_sleep(1); \
    if ((++_sp & 255u) == 0u) { if (xb_ld(&(bar)[XB_TMO])) break; if (_sp > XB_SPIN_CAP) { atomicAdd(&(bar)[XB_TMO], 1u); break; } } } } while (0)
struct XcdBarrier { unsigned* bar; unsigned x; volatile LAS unsigned* st; };
__device__ __forceinline__ XcdBarrier xcd_barrier_post(unsigned* bar, volatile LAS unsigned* st) {
    XcdBarrier b; b.bar = bar; b.x = xb_xcc_id(); b.st = st;
    if (threadIdx.x == 0) st[3] = xb_add(&bar[XB_XCNT(b.x)], 1u);
    return b;
}
__device__ __forceinline__ void xcd_barrier_complete(unsigned* bar, unsigned x, unsigned& nloc, unsigned& nx, unsigned& uni) {
    const unsigned G = gridDim.x * gridDim.y * gridDim.z;
    unsigned sum, cnt, mine, sp = 0u, ok32;
    for (;;) {
        sum = 0u; cnt = 0u; mine = 0u; ok32 = 1u;
#pragma unroll
        for (unsigned j = 0; j < 16; ++j) { const unsigned c = xb_ld(&bar[XB_XCNT(j)]); sum += c; cnt += (c > 0u) ? 1u : 0u; mine = (j == x) ? c : mine; ok32 &= (c == ((j < 8u) ? 32u : 0u)) ? 1u : 0u; }
        if (sum == G) break;
        __builtin_amdgcn_s_sleep(1);
        if ((++sp & 255u) == 0u) { if (xb_ld(&bar[XB_TMO])) break; if (sp > XB_SPIN_CAP) { atomicAdd(&bar[XB_TMO], 1u); break; } }
    }
    nloc = mine > 0u ? mine : 1u; nx = cnt > 0u ? cnt : 1u; uni = (sum == G && G == 256u) ? ok32 : 0u;
}
__device__ __forceinline__ void xcd_barrier(const XcdBarrier& b) {
    asm volatile("s_waitcnt vmcnt(0)" ::: "memory");
    __syncthreads();
    if (threadIdx.x == 0) {
        unsigned* bar = b.bar;
        __builtin_amdgcn_s_waitcnt(0);
        unsigned nloc = b.st[0], nx = b.st[1];
        if (nloc == 0u) { unsigned uni; xcd_barrier_complete(bar, b.x, nloc, nx, uni); b.st[0] = nloc; b.st[1] = nx; b.st[2] = uni; }
        const unsigned old = xb_add(&bar[XB_XSUB(b.x)], 1u);
        const unsigned gen = old / nloc;
        if (old + 1u == (gen + 1u) * nloc) {
            __builtin_amdgcn_fence(__ATOMIC_RELEASE, "agent");
            asm volatile("s_waitcnt vmcnt(0)" ::: "memory");
            const unsigned og = xb_add(&bar[XB_TOP], 1u);
            const unsigned tg = og / nx;
            if (og + 1u == (tg + 1u) * nx) xb_add(&bar[XB_TOPGEN], 1u);
            else XB_SPIN(xb_ld(&bar[XB_TOPGEN]) == tg, bar);
            __builtin_amdgcn_fence(__ATOMIC_ACQUIRE, "agent");
            xb_add(&bar[XB_XGEN(b.x)], 1u);
            asm volatile("s_waitcnt vmcnt(0)" ::: "memory");
        } else {
            XB_SPIN(xb_ld(&bar[XB_XGEN(b.x)]) == gen, bar);
            __builtin_amdgcn_fence(__ATOMIC_ACQUIRE, "agent");
            asm volatile("s_waitcnt vmcnt(0)" ::: "memory");
        }
    }
    __syncthreads();
}

__global__ void __launch_bounds__(512, 2) fwd_kernel(Args args) {
    extern __shared__ __attribute__((aligned(16))) unsigned char lds_raw[];
    LAS unsigned char* lds = (LAS unsigned char*)lds_raw;
    cg::grid_group grid = cg::this_grid();
    const int tid = threadIdx.x, lane = tid & 63, wave = __builtin_amdgcn_readfirstlane(tid >> 6);
    const int G = gridDim.x, bx = blockIdx.x;
    const int gw = bx * 8 + wave, NGW = G * 8;
    const int lo = args.ph_lo, hi = args.ph_hi;
#define IN(k) (lo <= (k) && (k) < hi)
#define BOTH(k) (IN(k) && IN((k) + 1))
    volatile LAS unsigned* bst = (volatile LAS unsigned*)(lds + LDS_BYTES - 64);
    if (tid < 16) bst[tid] = 0u;
    __syncthreads();
    const XcdBarrier gbar = xcd_barrier_post((unsigned*)(KWS + WS_BAR), bst);
    if (lo > 1000) grid.sync();
#define GRID_SYNC() xcd_barrier(gbar)

    if (IN(0)) { phase0(lds, bx, G, lane, wave); __syncthreads(); }
    if (IN(1)) { phase1(lds, gw, NGW, lane, wave); if (BOTH(1)) GRID_SYNC(); }
    int vb = bx;
    if (BOTH(1) && bst[2] != 0u) vb = __builtin_amdgcn_readfirstlane((int)(bst[3] * 8u + gbar.x));
    const bool split2 = (G == 256) && (hi - lo == 5);
    if (IN(2)) {
        EpiIn E;
        if (split2) {
            { SchedIn S{(const char*)KWS, vb, G, 0, 768}; pg8::gemm_phase<EpiIn, SchedIn>(lds, S, E); }
            GRID_SYNC();
            if (vb < 136) { SchedIn S{(const char*)KWS, vb, G, 768, 904}; pg8::gemm_phase<EpiIn, SchedIn>(lds, S, E); }
            else {
                const int j = vb - 136;
                unsigned char* ws = KWS;
                for (int cu = j; cu < SEQ / 32; cu += 120) conv_unit(ws, lds, 32 * cu);
                if (j >= 16) {
                    LAS float* scr = (LAS float*)(lds + wave * 16640);
                    const float* w_out = KIN(I_WOUT); bf16_t* WO = (bf16_t*)(ws + WS_WO);
                    for (int it = (j - 16) * 8 + wave; it < 32 * (DM / 64); it += 104 * 8) { const int kb = it / (DM / 64), nb = it % (DM / 64); transpose_item(w_out, DM, WO, kb * 64, nb * 64, false, scr, lane); }
                }
            }
        } else {
            SchedIn S{(const char*)KWS, vb, G, 0, 904};
            pg8::gemm_phase<EpiIn, SchedIn>(lds, S, E);
            if (G == 256 && vb >= 136) {
                LAS float* scr = (LAS float*)(lds + wave * 16640);
                const float* w_out = KIN(I_WOUT); bf16_t* WO = (bf16_t*)(KWS + WS_WO);
                for (int it = (vb - 136) * 8 + wave; it < 32 * (DM / 64); it += 120 * 8) { const int kb = it / (DM / 64), nb = it % (DM / 64); transpose_item(w_out, DM, WO, kb * 64, nb * 64, false, scr, lane); }
            }
        }
        if (BOTH(2)) GRID_SYNC();
    }
    if (IN(3)) {
        const float* lq1 = KIN(I_LQ1); const float* lk1 = KIN(I_LK1); const float* lq2 = KIN(I_LQ2); const float* lk2 = KIN(I_LK2);
        const float d1 = wave_sum(lq1[lane] * lk1[lane]), d2 = wave_sum(lq2[lane] * lk2[lane]);
        const float lam = __expf(d1) - __expf(d2) + LAM_INIT;
        const float* qg = KIN(I_QG); const float* kg = KIN(I_KG);
        const float mq = wave_max(fabsf(qg[lane])), mk = wave_max(fabsf(kg[lane]));
        const float negM = -(QSCALE * 64.0f * mq * mk * 1.01f);
        unsigned char* ws = KWS;
        if (!split2) for (int t0 = vb * 32; t0 < SEQ; t0 += G * 32) conv_unit(ws, lds, t0);
        const float* sub_g = KIN(I_SUBG);
        for (int u = vb; u < NH * (SEQ / 128); u += G) attn_unit(ws, sub_g, lds, u & 7, u >> 3, negM, lam);
        if (BOTH(3)) GRID_SYNC();
    }
    if (IN(4)) {
        SchedOut S{(const char*)KWS, vb, G};
        EpiOut E;
        pg8::gemm_phase<EpiOut, SchedOut>(lds, S, E);
    }
#undef IN
#undef BOTH
}

extern "C" void kernel_launch(void* const* d_in, const int* in_sizes, int n_in, void* d_out, int out_size, void* d_ws, size_t ws_size, hipStream_t stream) {
    static int grid = 0;
    if (grid == 0) {
        if (n_in != 20 || out_size != SEQ * DM || ws_size < WS_END) { fprintf(stderr, "kernel_launch: unexpected shapes (n_in %d out %d ws %zu)\n", n_in, out_size, ws_size); grid = -1; return; }
        int dev = 0, cus = 0, per_cu = 0;
        if (hipGetDevice(&dev) != hipSuccess || hipDeviceGetAttribute(&cus, hipDeviceAttributeMultiprocessorCount, dev) != hipSuccess) { grid = -1; return; }
        if (hipFuncSetAttribute((const void*)fwd_kernel, hipFuncAttributeMaxDynamicSharedMemorySize, LDS_BYTES) != hipSuccess) { fprintf(stderr, "kernel_launch: hipFuncSetAttribute failed\n"); grid = -1; return; }
        if (hipOccupancyMaxActiveBlocksPerMultiprocessor(&per_cu, (const void*)fwd_kernel, 512, LDS_BYTES) != hipSuccess || per_cu < 1) { fprintf(stderr, "kernel_launch: occupancy query gave %d\n", per_cu); per_cu = 1; }
        (void)hipGetLastError();
        grid = cus * 1;
    }
    if (grid < 0) return;
    (void)hipMemsetAsync((char*)d_ws + WS_MOD, 0, WS_ZERO_BYTES, stream);
    Args a{};
    for (int i = 0; i < 20; ++i) a.in[i] = (const float*)d_in[i];
    a.out = (float*)d_out; a.ws = (unsigned char*)d_ws;
#if MK_N_LAUNCHES == 1
    a.ph_lo = 0; a.ph_hi = 5;
    void* kargs[] = {&a};
    hipError_t e = hipLaunchCooperativeKernel((const void*)fwd_kernel, dim3(grid), dim3(512), kargs, LDS_BYTES, stream);
    if (e != hipSuccess) {
        fprintf(stderr, "cooperative launch failed: %s (grid %d); falling back to one launch per phase\n", hipGetErrorString(e), grid);
        (void)hipGetLastError();
        for (int ph = 0; ph < 5; ++ph) { a.ph_lo = ph; a.ph_hi = ph + 1; hipLaunchKernelGGL(fwd_kernel, dim3(grid), dim3(512), LDS_BYTES, stream, a); }
    }
#else
    for (int ph = 0; ph < 5; ++ph) {
        a.ph_lo = ph; a.ph_hi = ph + 1;
        hipLaunchKernelGGL(fwd_kernel, dim3(grid), dim3(512), LDS_BYTES, stream, a);
    }
#endif
}
```

```cpp
#include <hip/hip_runtime.h>
#include <hip/hip_cooperative_groups.h>
#include <cstdio>
#include <cstdint>
namespace cg = cooperative_groups;

#ifndef MK_N_LAUNCHES
#define MK_N_LAUNCHES 1
#endif

#define LAS __attribute__((address_space(3)))
typedef unsigned short bf16_t;
typedef short bf16x8 __attribute__((ext_vector_type(8)));
typedef float f32x2 __attribute__((ext_vector_type(2)));
typedef float f32x4 __attribute__((ext_vector_type(4)));
typedef float f32x16 __attribute__((ext_vector_type(16)));
typedef unsigned u32x2 __attribute__((ext_vector_type(2)));
typedef unsigned u32x4 __attribute__((ext_vector_type(4)));
typedef __bf16 bf16x2_t __attribute__((ext_vector_type(2)));

constexpr int DM = 2048, SEQ = 8192, CTXL = 256, NTOK = SEQ + CTXL, INW = 7168;
constexpr int NH = 8, HD = 64, VD = 128, ATTW = 1024, CONVW = 1024, CONVK = 31;
constexpr float EPS = 1e-6f;
constexpr float LOG2E = 1.4426950408889634f;
constexpr float QSCALE = 0.125f * LOG2E;
constexpr float LAM_INIT = 0.2f;

constexpr size_t MiB = 1u << 20;
constexpr size_t WS_MOD = 0;
constexpr size_t WS_BAR = 49152;
constexpr size_t WS_P0CNT = 63488;
constexpr size_t WS_ZERO_BYTES = 65536;
constexpr size_t WS_TAB = 65536;
constexpr size_t WS_WT = 1 * MiB;
constexpr size_t WS_WO = 29 * MiB;
constexpr size_t WS_H = 40 * MiB;
constexpr size_t WS_Q = 74 * MiB;
constexpr size_t WS_K = 90 * MiB;
constexpr size_t WS_VT = 107 * MiB;
constexpr size_t WS_GA = 124 * MiB;
constexpr size_t WS_Y = 140 * MiB;
constexpr size_t WS_GC = 156 * MiB;
constexpr size_t WS_MIX = 172 * MiB;
constexpr size_t WS_END = 204 * MiB;

constexpr int LDS_BYTES = 147456;

__device__ __forceinline__ unsigned cvtpk(float lo, float hi) { f32x2 v = {lo, hi}; bf16x2_t b = __builtin_convertvector(v, bf16x2_t); return __builtin_bit_cast(unsigned, b); }
__device__ __forceinline__ float bf_lo(unsigned u) { return __builtin_bit_cast(float, u << 16); }
__device__ __forceinline__ float bf_hi(unsigned u) { return __builtin_bit_cast(float, u & 0xffff0000u); }
__device__ __forceinline__ float wave_sum(float v) {
#pragma unroll
    for (int o = 1; o < 64; o <<= 1) v += __shfl_xor(v, o);
    return v;
}
__device__ __forceinline__ float wave_max(float v) {
#pragma unroll
    for (int o = 1; o < 64; o <<= 1) v = fmaxf(v, __shfl_xor(v, o));
    return v;
}
__device__ __forceinline__ float silu_f(float v) { return v * __builtin_amdgcn_rcpf(1.0f + __builtin_amdgcn_exp2f(-v * LOG2E)); }
__device__ __forceinline__ float sigmoid_f(float v) { return __builtin_amdgcn_rcpf(1.0f + __builtin_amdgcn_exp2f(-v * LOG2E)); }
__device__ __forceinline__ float fadd_s(float a, float b) { float r; asm("v_add_f32_e32 %0, %1, %2" : "=v"(r) : "v"(a), "v"(b)); return r; }
__device__ __forceinline__ int perm5(int f5) { return 16 * ((f5 >> 2) & 1) + 4 * (f5 >> 3) + (f5 & 3); }

namespace pg8 {
constexpr int BM = 256, BK = 64, HALF = 128, HTB = HALF * BK * 2, STAGE_BYTES = 8 * HTB;
constexpr int GK = 2048;
__device__ __forceinline__ int lds_byte(int r, int c) { const int st = (r >> 4) * 2 + (c >> 5), rr = r & 15, cc = c & 31, ob = rr * 64 + cc * 2; return st * 1024 + (ob ^ (((ob >> 9) & 1) << 5)); }
__device__ __forceinline__ void stage_rc(int b, int& R, int& C) { const int st = b / 1024, sb = b % 1024, swz = sb ^ (((sb >> 9) & 1) << 5); R = (st >> 1) * 16 + swz / 64; C = (st & 1) * 32 + (swz % 64) / 2; }

struct Unit { const char* a; const char* b; int kind, pm, pn; };

template <class Epi, class Sched>
__device__ __forceinline__ void gemm_phase(LAS unsigned char* lds, const Sched& S, const Epi& E) {
    const int tid = threadIdx.x, wid = __builtin_amdgcn_readfirstlane(tid >> 6), lane = tid & 63, wr = wid >> 2, wc = wid & 3, fr = lane & 15, fq = lane >> 4;
    constexpr int K = GK, nt = K / BK;
    unsigned voffA[2];
#pragma unroll
    for (int i = 0; i < 2; ++i) { int R, C; stage_rc(tid * 16 + i * 8192, R, C); voffA[i] = (unsigned)(R * K + C) * 2u; }
    const size_t kstep = (size_t)(BK * 2);
    const size_t hstep = (size_t)HALF * K * 2;
    const unsigned ldsw = (unsigned)wid * 1024u;
    const int aoff = lds_byte(wr * 64 + fr, fq * 8), boff = lds_byte(wc * 32 + fr, fq * 8);
#define PG8_SA(b, h) (((b) * 2 + (h)) * HTB)
#define PG8_SB(b, h) ((4 + (b) * 2 + (h)) * HTB)
#define PG8_STAGE(bufoff, gbase) do { _Pragma("unroll") for (int _i = 0; _i < 2; ++_i) \
        __builtin_amdgcn_global_load_lds((const unsigned*)((const char*)(gbase) + voffA[_i]), (LAS unsigned*)(lds + (bufoff) + ldsw + _i * 8192), 16, 0, 0); } while (0)
#define PG8_LDA(dst, b, h) do { _Pragma("unroll") for (int m = 0; m < 4; ++m) _Pragma("unroll") for (int k = 0; k < 2; ++k) dst[m][k] = *(const LAS bf16x8*)(lds + PG8_SA(b, h) + aoff + m * 2048 + k * 1024); } while (0)
#define PG8_LDB(dst, b, h) do { _Pragma("unroll") for (int n = 0; n < 2; ++n) _Pragma("unroll") for (int k = 0; k < 2; ++k) dst[n][k] = *(const LAS bf16x8*)(lds + PG8_SB(b, h) + boff + n * 2048 + k * 1024); } while (0)
#define PG8_MMA(ai, bj, At, Bt) do { __builtin_amdgcn_s_setprio(1); _Pragma("unroll") for (int m = 0; m < 4; ++m) _Pragma("unroll") for (int n = 0; n < 2; ++n) _Pragma("unroll") for (int k = 0; k < 2; ++k) \
        acc[ai][bj][m][n] = __builtin_amdgcn_mfma_f32_16x16x32_bf16(Bt[n][k], At[m][k], acc[ai][bj][m][n], 0, 0, 0); __builtin_amdgcn_s_setprio(0); } while (0)
#define PG8_WAIT_V(n) asm volatile("s_waitcnt vmcnt(" #n ")" ::: "memory")
#define PG8_WAIT_L(n) asm volatile("s_waitcnt lgkmcnt(" #n ")" ::: "memory")
#define PG8_BAR __builtin_amdgcn_s_barrier()
#define PG8_SCHED __builtin_amdgcn_sched_barrier(0)
    Unit cur, nxt; int ui = 0;
    if (!S.next(0, cur)) return;
    f32x4 acc[2][2][4][2];
#pragma unroll
    for (int a = 0; a < 2; ++a)
#pragma unroll
        for (int b = 0; b < 2; ++b)
#pragma unroll
            for (int m = 0; m < 4; ++m)
#pragma unroll
                for (int n = 0; n < 2; ++n) acc[a][b][m][n] = (f32x4){0.f, 0.f, 0.f, 0.f};
    bf16x8 At[4][2], B0[2][2], B1[2][2];
    const char* cA = cur.a; const char* cB = cur.b;
    PG8_STAGE(PG8_SB(0, 0), cB); PG8_STAGE(PG8_SB(0, 1), cB + hstep); PG8_STAGE(PG8_SA(0, 0), cA); PG8_STAGE(PG8_SA(0, 1), cA + hstep);
    if (wr == 1) PG8_BAR;
    PG8_WAIT_V(2); PG8_BAR;
    PG8_STAGE(PG8_SB(1, 0), cB + kstep); PG8_STAGE(PG8_SA(1, 0), cA + kstep); PG8_STAGE(PG8_SB(1, 1), cB + hstep + kstep);
    PG8_WAIT_V(6); PG8_BAR;
    for (;;) {
        const bool has_next = S.next(ui + 1, nxt);
        const char* nA = has_next ? nxt.a : cA; const char* nB = has_next ? nxt.b : cB;
        for (int t = 0; t < nt; t += 2) {
            const bool last = (t == nt - 2);
            const char* a1 = cA + (size_t)(t + 1) * kstep;
            const char* a2 = last ? nA : cA + (size_t)(t + 2) * kstep; const char* b2 = last ? nB : cB + (size_t)(t + 2) * kstep;
            const char* a3 = a2 + kstep; const char* b3 = b2 + kstep;
            PG8_LDB(B0, 0, 0); PG8_LDB(B1, 0, 1); PG8_SCHED; PG8_LDA(At, 0, 0); PG8_STAGE(PG8_SA(1, 1), a1 + hstep);
            PG8_WAIT_V(8); PG8_WAIT_L(0); PG8_BAR; PG8_MMA(0, 0, At, B0); PG8_MMA(0, 1, At, B1); PG8_BAR; PG8_SCHED;
            PG8_LDA(At, 0, 1); PG8_STAGE(PG8_SB(0, 0), b2); PG8_STAGE(PG8_SB(0, 1), b2 + hstep); PG8_STAGE(PG8_SA(0, 0), a2);
            PG8_WAIT_V(8); PG8_WAIT_L(0); PG8_BAR; PG8_MMA(1, 0, At, B0); PG8_MMA(1, 1, At, B1); PG8_BAR; PG8_SCHED;
            PG8_LDB(B0, 1, 0); PG8_LDB(B1, 1, 1); PG8_SCHED; PG8_LDA(At, 1, 0); PG8_STAGE(PG8_SA(0, 1), a2 + hstep);
            PG8_WAIT_V(8); PG8_WAIT_L(0); PG8_BAR; PG8_MMA(0, 0, At, B0); PG8_MMA(0, 1, At, B1); PG8_BAR; PG8_SCHED;
            PG8_LDA(At, 1, 1); PG8_STAGE(PG8_SB(1, 0), b3); PG8_STAGE(PG8_SB(1, 1), b3 + hstep); PG8_STAGE(PG8_SA(1, 0), a3);
            PG8_WAIT_V(8); PG8_WAIT_L(0); PG8_BAR; PG8_MMA(1, 0, At, B0); PG8_MMA(1, 1, At, B1); PG8_BAR; PG8_SCHED;
        }
        if (wr == 0) PG8_BAR;
        E(acc, cur, wr, wc, fr, fq);
        if (!has_next) break;
#pragma unroll
        for (int a = 0; a < 2; ++a)
#pragma unroll
            for (int b = 0; b < 2; ++b)
#pragma unroll
                for (int m = 0; m < 4; ++m)
#pragma unroll
                    for (int n = 0; n < 2; ++n) acc[a][b][m][n] = (f32x4){0.f, 0.f, 0.f, 0.f};
        cur = nxt; cA = nA; cB = nB; ++ui;
        if (wr == 1) PG8_BAR;
    }
    PG8_WAIT_V(0);
    PG8_BAR;
#undef PG8_SA
#undef PG8_SB
#undef PG8_STAGE
#undef PG8_LDA
#undef PG8_LDB
#undef PG8_MMA
#undef PG8_WAIT_V
#undef PG8_WAIT_L
#undef PG8_BAR
#undef PG8_SCHED
}
}

struct Args { const float* in[20]; float* out; unsigned char* ws; int ph_lo, ph_hi; };
template <int OFF> __device__ __forceinline__ unsigned long long karg64() {
    unsigned long long v;
    asm volatile("s_load_dwordx2 %0, %1, %2\n\ts_waitcnt lgkmcnt(0)" : "=s"(v) : "s"(__builtin_amdgcn_kernarg_segment_ptr()), "n"(OFF) : "memory");
    return v;
}
#define GAS __attribute__((address_space(1)))
#define KIN(i) ((const float*)(GAS const float*)karg64<8 * (i)>())
#define KOUT ((float*)(GAS float*)karg64<160>())
#define KWS ((unsigned char*)(GAS unsigned char*)karg64<168>())
enum { I_X = 0, I_C, I_CTX, I_CCTX, I_WADA, I_BADA, I_NORMG, I_WIN, I_QG, I_KG, I_LQ1, I_LK1, I_LQ2, I_LK2, I_SUBG, I_CONVW, I_CONVB, I_LNG, I_LNB, I_WOUT };

struct SchedIn {
    const char* ws; int c, G, L0, L1;
    __device__ __forceinline__ bool next(int i, pg8::Unit& u) const {
        const int L = L0 + i * G + c; if (L >= L1) return false;
        constexpr size_t RB = (size_t)DM * 2;
        const char* H = ws + WS_H; const char* WT = ws + WS_WT;
        if (L < 768) {
            int wgid = (L % 8) * 96 + L / 8;
            const int gid = wgid / 192, rem = wgid % 192;
            const int pm = gid * 8 + (rem % 8), pn = rem / 8;
            u.a = H + (size_t)(256 + 256 * pm) * RB; u.b = WT + (size_t)(256 * pn) * RB; u.pm = pm; u.pn = pn;
            u.kind = (pn < 8) ? 0 : ((pn >= 12 && pn < 20) ? 2 : 1);
        } else if (L < 900) {
            const int idx = L - 768, pm = idx & 3, pn = idx >> 2;
            u.a = WT + (size_t)(6144 + 256 * pm) * RB; u.b = H + (size_t)(256 * pn) * RB; u.pm = pm; u.pn = pn; u.kind = 3;
        } else {
            const int pn = L - 900;
            u.a = H; u.b = WT + (size_t)(1024 + 256 * pn) * RB; u.pm = 0; u.pn = pn; u.kind = 4;
        }
        return true;
    }
};
struct SchedOut {
    const char* ws; int c, G;
    __device__ __forceinline__ bool next(int i, pg8::Unit& u) const {
        const int L = i * G + c; if (L >= 256) return false;
        constexpr size_t RB = (size_t)DM * 2;
        int wgid = (L % 8) * 32 + L / 8;
        const int gid = wgid / 64, rem = wgid % 64;
        const int pm = gid * 8 + (rem % 8), pn = rem / 8;
        u.a = ws + WS_MIX + (size_t)(256 * pm) * RB; u.b = ws + WS_WO + (size_t)(256 * pn) * RB; u.pm = pm; u.pn = pn; u.kind = 5;
        return true;
    }
};

struct EpiIn {
    __device__ __forceinline__ void operator()(const f32x4 (&acc)[2][2][4][2], const pg8::Unit& u, int wr, int wc, int fr, int fq) const {
        const int kind = u.kind;
        unsigned char* ws = KWS;
        if (kind == 0 || kind == 4) {
            const bool isq = (kind == 0) && (u.pn < 4);
            const float* gsrc = isq ? KIN(I_QG) : KIN(I_KG);
            const float osc = isq ? QSCALE : 1.0f;
            const f32x2* tab = (const f32x2*)(ws + WS_TAB);
            f32x4 g[2][2];
#pragma unroll
            for (int bj = 0; bj < 2; ++bj)
#pragma unroll
                for (int n = 0; n < 2; ++n) g[bj][n] = *(const f32x4*)(gsrc + 32 * bj + 16 * n + 4 * fq);
            bf16_t* dst = (bf16_t*)(ws + (isq ? WS_Q : WS_K));
            const int rowoff = (kind == 0 && !isq) ? CTXL : 0;
            const int G = 4 * (u.pn & 3) + wc;
#pragma unroll
            for (int ai = 0; ai < 2; ++ai) {
                const int rpos = 4 * u.pm + 2 * ai + wr;
                f32x4 cr0, cr1;
                if (kind == 0) { const f32x4* tp = (const f32x4*)(tab + rpos * 16 + 4 * fq); cr0 = tp[0]; cr1 = tp[1]; }
                else { cr0 = (f32x4){1.f, 0.f, 1.f, 0.f}; cr1 = cr0; }
#pragma unroll
                for (int m = 0; m < 4; ++m) {
                    const int t = 256 * u.pm + 128 * ai + 64 * wr + 16 * m + fr;
                    float ss = 0.f;
#pragma unroll
                    for (int bj = 0; bj < 2; ++bj)
#pragma unroll
                        for (int n = 0; n < 2; ++n) { const f32x4 v = acc[ai][bj][m][n]; ss += (v[0] * v[0] + v[1] * v[1]) + (v[2] * v[2] + v[3] * v[3]); }
                    ss += __shfl_xor(ss, 16); ss += __shfl_xor(ss, 32);
                    const float rstd = __builtin_amdgcn_rsqf(ss * (1.0f / 64.0f) + EPS) * osc;
                    f32x4 cc0, cc1;
                    if (kind == 0) { const f32x4* tp = (const f32x4*)(tab + (16 * m + fr) * 16 + 4 * fq); cc0 = tp[0]; cc1 = tp[1]; }
                    else { cc0 = (f32x4){1.f, 0.f, 1.f, 0.f}; cc1 = cc0; }
                    bf16_t* rowp = dst + (size_t)(rowoff + t) * 1024 + G * 64 + 8 * fq;
#pragma unroll
                    for (int bj = 0; bj < 2; ++bj) {
                        const f32x4 x1 = acc[ai][bj][m][0] * g[bj][0] * rstd, x2 = acc[ai][bj][m][1] * g[bj][1] * rstd;
                        const f32x4 ca = bj == 0 ? cr0 : cc0, cb = bj == 0 ? cr1 : cc1;
                        const float co[4] = {ca[0], ca[2], cb[0], cb[2]}, si[4] = {ca[1], ca[3], cb[1], cb[3]};
                        float o1[4], o2[4];
#pragma unroll
                        for (int e = 0; e < 4; ++e) { o1[e] = x1[e] * co[e] - x2[e] * si[e]; o2[e] = x2[e] * co[e] + x1[e] * si[e]; }
                        u32x4 w; w.x = cvtpk(o1[0], o1[1]); w.y = cvtpk(o1[2], o1[3]); w.z = cvtpk(o2[0], o2[1]); w.w = cvtpk(o2[2], o2[3]);
                        *(u32x4*)(rowp + 32 * bj) = w;
                    }
                }
            }
        } else if (kind == 1) {
            const bool isa = u.pn < 12; const int pnl = isa ? (u.pn - 8) : (u.pn - 20);
            bf16_t* dst = (bf16_t*)(ws + (isa ? WS_GA : WS_GC));
#pragma unroll
            for (int ai = 0; ai < 2; ++ai)
#pragma unroll
                for (int m = 0; m < 4; ++m) {
                    const int t = 256 * u.pm + 128 * ai + 64 * wr + 16 * m + fr;
                    bf16_t* rowp = dst + (size_t)t * 1024 + 256 * pnl + 32 * wc + 8 * fq;
#pragma unroll
                    for (int bj = 0; bj < 2; ++bj) {
                        const f32x4 v0 = acc[ai][bj][m][0], v1 = acc[ai][bj][m][1];
                        u32x4 w; w.x = cvtpk(silu_f(v0[0]), silu_f(v0[1])); w.y = cvtpk(silu_f(v0[2]), silu_f(v0[3]));
                        w.z = cvtpk(silu_f(v1[0]), silu_f(v1[1])); w.w = cvtpk(silu_f(v1[2]), silu_f(v1[3]));
                        *(u32x4*)(rowp + 128 * bj) = w;
                    }
                }
        } else if (kind == 2) {
            const int pnl = u.pn - 12;
            bf16_t* Y = (bf16_t*)(ws + WS_Y);
#pragma unroll
            for (int ai = 0; ai < 2; ++ai)
#pragma unroll
                for (int m = 0; m < 4; ++m) {
                    const int t = 256 * u.pm + 128 * ai + 64 * wr + 16 * m + fr;
                    bf16_t* rowp = Y + (size_t)t * 1024 + 128 * pnl + 32 * wc + 8 * fq;
                    const f32x4 a0 = acc[ai][0][m][0], a1 = acc[ai][0][m][1], g0 = acc[ai][1][m][0], g1 = acc[ai][1][m][1];
                    u32x4 w; w.x = cvtpk(a0[0] * sigmoid_f(g0[0]), a0[1] * sigmoid_f(g0[1])); w.y = cvtpk(a0[2] * sigmoid_f(g0[2]), a0[3] * sigmoid_f(g0[3]));
                    w.z = cvtpk(a1[0] * sigmoid_f(g1[0]), a1[1] * sigmoid_f(g1[1])); w.w = cvtpk(a1[2] * sigmoid_f(g1[2]), a1[3] * sigmoid_f(g1[3]));
                    *(u32x4*)rowp = w;
                }
        } else {
            const int sfq = (fq == 1) ? 2 : ((fq == 2) ? 1 : fq);
            bf16_t* VT = (bf16_t*)(ws + WS_VT);
#pragma unroll
            for (int ai = 0; ai < 2; ++ai)
#pragma unroll
                for (int m = 0; m < 4; ++m) {
                    const int f = 256 * u.pm + 128 * ai + 64 * wr + 16 * m + fr;
                    bf16_t* rowp = VT + (size_t)f * NTOK + 256 * u.pn + 32 * wc + 4 * sfq;
#pragma unroll
                    for (int bj = 0; bj < 2; ++bj)
#pragma unroll
                        for (int n = 0; n < 2; ++n) { const f32x4 v = acc[ai][bj][m][n]; u32x2 w; w.x = cvtpk(v[0], v[1]); w.y = cvtpk(v[2], v[3]); *(u32x2*)(rowp + 128 * bj + 16 * n) = w; }
                }
        }
    }
};
struct EpiOut {
    __device__ __forceinline__ void operator()(const f32x4 (&acc)[2][2][4][2], const pg8::Unit& u, int wr, int wc, int fr, int fq) const {
        const float* gate = (const float*)(KWS + WS_MOD) + 4096; const float* gb = KIN(I_BADA) + 4096;
        const float* x = KIN(I_X); float* out = KOUT;
        const int col0 = 256 * u.pn + 32 * wc + 4 * fq;
        f32x4 gv[2][2];
#pragma unroll
        for (int bj = 0; bj < 2; ++bj)
#pragma unroll
            for (int n = 0; n < 2; ++n) gv[bj][n] = *(const f32x4*)(gate + col0 + 128 * bj + 16 * n) + *(const f32x4*)(gb + col0 + 128 * bj + 16 * n);
#pragma unroll
        for (int ai = 0; ai < 2; ++ai)
#pragma unroll
            for (int mh = 0; mh < 2; ++mh) {
                f32x4 xv[2][2][2];
#pragma unroll
                for (int mm = 0; mm < 2; ++mm) {
                    const size_t off = (size_t)(256 * u.pm + 128 * ai + 64 * wr + 16 * (2 * mh + mm) + fr) * DM + col0;
#pragma unroll
                    for (int bj = 0; bj < 2; ++bj)
#pragma unroll
                        for (int n = 0; n < 2; ++n) xv[mm][bj][n] = *(const f32x4*)(x + off + 128 * bj + 16 * n);
                }
#pragma unroll
                for (int mm = 0; mm < 2; ++mm) {
                    const size_t off = (size_t)(256 * u.pm + 128 * ai + 64 * wr + 16 * (2 * mh + mm) + fr) * DM + col0;
#pragma unroll
                    for (int bj = 0; bj < 2; ++bj)
#pragma unroll
                        for (int n = 0; n < 2; ++n) *(f32x4*)(out + off + 128 * bj + 16 * n) = xv[mm][bj][n] + gv[bj][n] * acc[ai][bj][2 * mh + mm][n];
                }
            }
    }
};

__device__ __forceinline__ int win_dest_row(int s) {
    if (s < 2048) { const int base = s & ~1023, ss = s & 1023, G = ss >> 6, d = ss & 63; return base + 256 * (G >> 2) + 128 * (d >> 5) + 32 * (G & 3) + (d & 31); }
    if (s < 3072) return 6144 + (s - 2048);
    if (s < 4096) { const int f = s - 3072; return 2048 + (f & ~31) + perm5(f & 31); }
    if (s < 6144) { const int isg = s >= 5120 ? 1 : 0, ch = s - 4096 - 1024 * isg; return 3072 + 256 * (ch >> 7) + 128 * isg + (ch & 96) + perm5(ch & 31); }
    const int f = s - 6144; return 5120 + (f & ~31) + perm5(f & 31);
}
__device__ __forceinline__ void transpose_item(const float* W, int N, bf16_t* WT, int k0, int n0, bool is_in, LAS float* scr, int lane) {
    const int lr = lane >> 4, lc = (lane & 15) * 4;
    f32x4 v[16];
#pragma unroll
    for (int i = 0; i < 16; ++i) v[i] = __builtin_nontemporal_load((const f32x4*)(W + (size_t)(k0 + 4 * i + lr) * N + n0 + lc));
#pragma unroll
    for (int i = 0; i < 16; ++i) { LAS float* d = scr + (4 * i + lr) * 65 + lc; d[0] = v[i][0]; d[1] = v[i][1]; d[2] = v[i][2]; d[3] = v[i][3]; }
    asm volatile("s_waitcnt lgkmcnt(0)" ::: "memory");
    const int c = lane & 7;
#pragma unroll
    for (int j = 0; j < 8; ++j) {
        const int n = (lane >> 3) + 8 * j; const LAS float* s = scr + (8 * c) * 65 + n;
        u32x4 o; o.x = cvtpk(s[0 * 65], s[1 * 65]); o.y = cvtpk(s[2 * 65], s[3 * 65]); o.z = cvtpk(s[4 * 65], s[5 * 65]); o.w = cvtpk(s[6 * 65], s[7 * 65]);
        const int dr = is_in ? win_dest_row(n0 + n) : (n0 + n);
        *(u32x4*)(WT + (size_t)dr * DM + k0 + 8 * c) = o;
    }
    asm volatile("s_waitcnt lgkmcnt(0)" ::: "memory");
}

__device__ __forceinline__ void phase0(LAS unsigned char* lds, int bx, int G, int lane, int wave) {
    unsigned char* ws = KWS;
    const float* w_ada = KIN(I_WADA); const float* cv = KIN(I_C); const float* ccv = KIN(I_CCTX);
    float* modx = (float*)(ws + WS_MOD);
    LAS float* red = (LAS float*)lds;
    for (int wi = bx; wi < 256; wi += G) {
        const int cc = wi & 31, kb = ((wi >> 5) * 8 + wave) * 32, cb = cc * 192 + lane * 4;
        f32x4 ax = {0.f, 0.f, 0.f, 0.f}, ac = {0.f, 0.f, 0.f, 0.f};
        if (lane < 48) {
#pragma unroll
            for (int k = 0; k < 32; ++k) {
                const f32x4 w = __builtin_nontemporal_load((const f32x4*)(w_ada + (size_t)(kb + k) * 6144 + cb));
                const float sx = silu_f(cv[kb + k]), sc = silu_f(ccv[kb + k]);
                ax += w * sx; ac += w * sc;
            }
            *(LAS f32x4*)(red + (wave * 2 + 0) * 192 + lane * 4) = ax;
            *(LAS f32x4*)(red + (wave * 2 + 1) * 192 + lane * 4) = ac;
        }
        __syncthreads();
        {
            const int t = threadIdx.x;
            if (t < 384) {
                const int vec = t / 192, col = t - vec * 192;
                float s = 0.f;
#pragma unroll
                for (int w = 0; w < 8; ++w) s += red[(w * 2 + vec) * 192 + col];
                unsafeAtomicAdd(modx + vec * 6144 + cc * 192 + col, s);
            }
        }
        __syncthreads();
    }
    asm volatile("s_waitcnt vmcnt(0)" ::: "memory");
    __syncthreads();
    if (threadIdx.x == 0) __hip_atomic_fetch_add((unsigned*)(ws + WS_P0CNT), 1u, __ATOMIC_RELAXED, __HIP_MEMORY_SCOPE_AGENT);
    {
        const int gt = (bx * 8 + wave) * 64 + lane;
        if (gt < 2048) {
            const int p = gt >> 4, f = gt & 15;
            const float inv = exp2f(-(float)f * (13.287712379549449f / 16.0f));
            const float ang = (float)p * inv;
            float rev = ang * 0.15915494309189535f; rev -= floorf(rev);
            ((f32x2*)(ws + WS_TAB))[gt] = (f32x2){__builtin_amdgcn_cosf(rev), __builtin_amdgcn_sinf(rev)};
        }
    }
}

__device__ __forceinline__ void phase1(LAS unsigned char* lds, int gw, int NGW, int lane, int wave) {
    unsigned char* ws = KWS;
    {
        LAS float* scr = (LAS float*)(lds + wave * 16640);
        const float* w_in = KIN(I_WIN); const float* w_out = KIN(I_WOUT);
        bf16_t* WT = (bf16_t*)(ws + WS_WT); bf16_t* WO = (bf16_t*)(ws + WS_WO);
        constexpr int NB_IN = INW / 64, NB_OUT = DM / 64, I_IN = 32 * NB_IN, I_OUT = 32 * NB_OUT;
        const int n_items = (NGW == 2048) ? I_IN : I_IN + I_OUT;
        for (int it = (NGW - 1 - gw); it < n_items; it += NGW) {
            if (it < I_IN) { const int kb = it / NB_IN, nb = it % NB_IN; transpose_item(w_in, INW, WT, kb * 64, nb * 64, true, scr, lane); }
            else { const int r2 = it - I_IN, kb = r2 / NB_OUT, nb = r2 % NB_OUT; transpose_item(w_out, DM, WO, kb * 64, nb * 64, false, scr, lane); }
        }
    }
    if (threadIdx.x == 0) {
        unsigned* cnt = (unsigned*)(ws + WS_P0CNT); const unsigned want = gridDim.x; unsigned spins = 0;
        while (__hip_atomic_load(cnt, __ATOMIC_RELAXED, __HIP_MEMORY_SCOPE_AGENT) < want) { __builtin_amdgcn_s_sleep(2); if (++spins > (1u << 20)) break; }
    }
    __syncthreads();
    const float* x = KIN(I_X); const float* ctx = KIN(I_CTX);
    {
        const float* b_ada = KIN(I_BADA); const float* norm_g = KIN(I_NORMG);
        float* modx = (float*)(ws + WS_MOD); float* modc = modx + 6144;
        const int col = threadIdx.x * 4;
        const f32x4 g = *(const f32x4*)(norm_g + col), bsh = *(const f32x4*)(b_ada + col), bsc = *(const f32x4*)(b_ada + 2048 + col);
        f32x4 sx, hx, sc, hc;
#pragma unroll
        for (int e = 0; e < 4; ++e) {
            sx[e] = __hip_atomic_load(modx + 2048 + col + e, __ATOMIC_RELAXED, __HIP_MEMORY_SCOPE_AGENT); hx[e] = __hip_atomic_load(modx + col + e, __ATOMIC_RELAXED, __HIP_MEMORY_SCOPE_AGENT);
            sc[e] = __hip_atomic_load(modc + 2048 + col + e, __ATOMIC_RELAXED, __HIP_MEMORY_SCOPE_AGENT); hc[e] = __hip_atomic_load(modc + col + e, __ATOMIC_RELAXED, __HIP_MEMORY_SCOPE_AGENT);
        }
        *(LAS f32x4*)(lds + 0 * 8192 + col * 4) = g * (1.0f + sx + bsc);
        *(LAS f32x4*)(lds + 1 * 8192 + col * 4) = hx + bsh;
        *(LAS f32x4*)(lds + 2 * 8192 + col * 4) = g * (1.0f + sc + bsc);
        *(LAS f32x4*)(lds + 3 * 8192 + col * 4) = hc + bsh;
    }
    __syncthreads();
    bf16_t* H = (bf16_t*)(ws + WS_H);
    f32x4 cur[8], nxt[8];
    int r = gw;
    if (r < NTOK) {
        const float* src = (r < CTXL) ? ctx + (size_t)r * DM : x + (size_t)(r - CTXL) * DM;
#pragma unroll
        for (int j = 0; j < 8; ++j) cur[j] = *(const f32x4*)(src + (lane + 64 * j) * 4);
    }
    for (; r < NTOK; r += NGW) {
        const int rn = r + NGW;
        if (rn < NTOK) {
            const float* src = (rn < CTXL) ? ctx + (size_t)rn * DM : x + (size_t)(rn - CTXL) * DM;
#pragma unroll
            for (int j = 0; j < 8; ++j) nxt[j] = *(const f32x4*)(src + (lane + 64 * j) * 4);
        }
        float ss = 0.f;
#pragma unroll
        for (int j = 0; j < 8; ++j) ss += (cur[j][0] * cur[j][0] + cur[j][1] * cur[j][1]) + (cur[j][2] * cur[j][2] + cur[j][3] * cur[j][3]);
        const float rstd = __builtin_amdgcn_rsqf(wave_sum(ss) * (1.0f / DM) + EPS);
        const int sel = (r < CTXL) ? 2 * 8192 : 0;
        bf16_t* dst = H + (size_t)r * DM;
#pragma unroll
        for (int j = 0; j < 8; ++j) {
            const int col = (lane + 64 * j) * 4;
            const f32x4 ge = *(const LAS f32x4*)(lds + sel + col * 4), sh = *(const LAS f32x4*)(lds + sel + 8192 + col * 4);
            const f32x4 o = cur[j] * rstd * ge + sh;
            u32x2 w; w.x = cvtpk(o[0], o[1]); w.y = cvtpk(o[2], o[3]);
            *(u32x2*)(dst + col) = w;
        }
#pragma unroll
        for (int j = 0; j < 8; ++j) cur[j] = nxt[j];
    }
    __syncthreads();
}

constexpr int AT_KBYTES = 16384, AT_VBYTES = 16384, AT_BUF = AT_KBYTES + AT_VBYTES;
constexpr int AT_XOFF = 0;
constexpr int AT_NT = NTOK / 64;
static_assert(3 * AT_BUF <= LDS_BYTES - 64, "attention ring");

__device__ __forceinline__ void attn_unit(unsigned char* ws, const float* sub_g, LAS unsigned char* lds, int h, int qb, float negM, float lam) {
    const int tid = threadIdx.x, lane = tid & 63, r32 = lane & 31, hi = lane >> 5;
    const int wid = __builtin_amdgcn_readfirstlane(tid >> 6), map = wid >> 2, wq = wid & 3;
    const int qrow0 = qb * 128 + 32 * wq;
    const bf16_t* Qp = (const bf16_t*)(ws + WS_Q); const bf16_t* Kp = (const bf16_t*)(ws + WS_K); const bf16_t* VTp = (const bf16_t*)(ws + WS_VT);
    bf16x8 qf[4];
    {
        const bf16_t* qp = Qp + (size_t)(qrow0 + r32) * 1024 + (h * 2 + map) * 64 + 8 * hi;
#pragma unroll
        for (int d0 = 0; d0 < 4; ++d0) qf[d0] = *(const bf16x8*)(qp + 16 * d0);
    }
    const bf16_t* kg[2]; const bf16_t* vg[2];
#pragma unroll
    for (int i = 0; i < 2; ++i) {
        const int g = 2 * wid + i;
        const int kr = 4 * g + (lane >> 4), kc = (lane & 15) ^ (kr & 15);
        kg[i] = Kp + (size_t)kr * 1024 + h * 128 + kc * 8;
        const int vr = 8 * g + (lane >> 3), vc = (lane & 7) ^ ((vr >> 1) & 7);
        vg[i] = VTp + (size_t)(h * 128 + vr) * NTOK + vc * 8;
    }
    const unsigned dmaoff = (unsigned)wid * 2048u;
#define AT_DMA(B) do { _Pragma("unroll") for (int i_ = 0; i_ < 2; ++i_) { \
        __builtin_amdgcn_global_load_lds((const unsigned*)kg[i_], (LAS unsigned*)(lds + (B) + dmaoff + i_ * 1024), 16, 0, 0); \
        __builtin_amdgcn_global_load_lds((const unsigned*)vg[i_], (LAS unsigned*)(lds + (B) + AT_KBYTES + dmaoff + i_ * 1024), 16, 0, 0); } } while (0)
#define AT_ADV() do { kg[0] += 64 * 1024; kg[1] += 64 * 1024; vg[0] += 64; vg[1] += 64; } while (0)
    int kad[4], vad[4];
#pragma unroll
    for (int d0 = 0; d0 < 4; ++d0) kad[d0] = r32 * 256 + (((map * 8 + 2 * d0 + hi) ^ (r32 & 15)) << 4);
#pragma unroll
    for (int j = 0; j < 4; ++j) vad[j] = AT_KBYTES + r32 * 128 + (((2 * j + hi) ^ ((r32 >> 1) & 7)) << 4);
#define SB() __builtin_amdgcn_sched_barrier(0)
#define KFR(B, d0, kh) (*(const LAS bf16x8*)(lds + (B) + kad[d0] + (kh) * 8192))
#define VFR(B, j, b) (*(const LAS bf16x8*)(lds + (B) + vad[j] + (b) * 4096))
    f32x16 o[4];
#pragma unroll
    for (int b = 0; b < 4; ++b)
#pragma unroll
        for (int r = 0; r < 16; ++r) o[b][r] = 0.f;
    f32x16 negm;
#pragma unroll
    for (int r = 0; r < 16; ++r) negm[r] = negM;
    float l0 = 0.f, l1 = 0.f;
    AT_DMA(0); AT_ADV();
    asm volatile("s_waitcnt vmcnt(0)" ::: "memory");
    __builtin_amdgcn_s_barrier();
    AT_DMA(AT_BUF); AT_ADV();
    f32x16 pa, pb;
    {
        f32x16 s0 = negm, s1 = negm;
#pragma unroll
        for (int d0 = 0; d0 < 4; ++d0) { s0 = __builtin_amdgcn_mfma_f32_32x32x16_bf16(KFR(0, d0, 0), qf[d0], s0, 0, 0, 0); s1 = __builtin_amdgcn_mfma_f32_32x32x16_bf16(KFR(0, d0, 1), qf[d0], s1, 0, 0, 0); }
#pragma unroll
        for (int r = 0; r < 16; ++r) { pa[r] = __builtin_amdgcn_exp2f(s0[r]); pb[r] = __builtin_amdgcn_exp2f(s1[r]); }
    }
    asm volatile("s_waitcnt vmcnt(0) lgkmcnt(0)" ::: "memory");
    __builtin_amdgcn_s_barrier();
    int bV = 0, bK = AT_BUF, bW = 2 * AT_BUF;
    u32x4 pw[4];
    for (int t = 1; t < AT_NT; ++t) {
        AT_DMA(bW);
        if (t + 2 < AT_NT) AT_ADV();
        SB();
#define FADDR(i) (((i) < 8) ? (bK + kad[(i) >> 1] + ((i) & 1) * 8192) : (bV + vad[((i) - 8) >> 2] + (((i) - 8) & 3) * 4096))
#define FLOAD(i) (*(const LAS bf16x8*)(lds + FADDR(i)))
#define ADD4(P, base) do { l0 = fadd_s(l0, P[base]); l1 = fadd_s(l1, P[base + 1]); l0 = fadd_s(l0, P[base + 2]); l1 = fadd_s(l1, P[base + 3]); } while (0)
#define EXP2(S, P, base) do { P[base] = __builtin_amdgcn_exp2f(S[base]); P[base + 1] = __builtin_amdgcn_exp2f(S[base + 1]); } while (0)
        f32x16 s0, s1;
        bf16x8 F0 = FLOAD(0), F1 = FLOAD(1), F2;
        SB();
        F2 = FLOAD(2); s0 = __builtin_amdgcn_mfma_f32_32x32x16_bf16(F0, qf[0], negm, 0, 0, 0); ADD4(pa, 0); pw[0][0] = cvtpk(pa[0], pa[1]); SB();
        F0 = FLOAD(3); s1 = __builtin_amdgcn_mfma_f32_32x32x16_bf16(F1, qf[0], negm, 0, 0, 0); ADD4(pa, 4); pw[0][1] = cvtpk(pa[2], pa[3]); SB();
        F1 = FLOAD(4); s0 = __builtin_amdgcn_mfma_f32_32x32x16_bf16(F2, qf[1], s0, 0, 0, 0); ADD4(pa, 8); pw[0][2] = cvtpk(pa[4], pa[5]); SB();
        F2 = FLOAD(5); s1 = __builtin_amdgcn_mfma_f32_32x32x16_bf16(F0, qf[1], s1, 0, 0, 0); ADD4(pa, 12); pw[0][3] = cvtpk(pa[6], pa[7]); SB();
        F0 = FLOAD(6); s0 = __builtin_amdgcn_mfma_f32_32x32x16_bf16(F1, qf[2], s0, 0, 0, 0); ADD4(pb, 0); pw[1][0] = cvtpk(pa[8], pa[9]); SB();
        F1 = FLOAD(7); s1 = __builtin_amdgcn_mfma_f32_32x32x16_bf16(F2, qf[2], s1, 0, 0, 0); ADD4(pb, 4); pw[1][1] = cvtpk(pa[10], pa[11]); SB();
        F2 = FLOAD(8); s0 = __builtin_amdgcn_mfma_f32_32x32x16_bf16(F0, qf[3], s0, 0, 0, 0); ADD4(pb, 8); pw[1][2] = cvtpk(pa[12], pa[13]); SB();
        F0 = FLOAD(9); s1 = __builtin_amdgcn_mfma_f32_32x32x16_bf16(F1, qf[3], s1, 0, 0, 0); ADD4(pb, 12); pw[1][3] = cvtpk(pa[14], pa[15]); SB();
        F1 = FLOAD(10); o[0] = __builtin_amdgcn_mfma_f32_32x32x16_bf16(F2, __builtin_bit_cast(bf16x8, pw[0]), o[0], 0, 0, 0); pw[2][0] = cvtpk(pb[0], pb[1]); EXP2(s0, pa, 0); SB();
        F2 = FLOAD(11); o[1] = __builtin_amdgcn_mfma_f32_32x32x16_bf16(F0, __builtin_bit_cast(bf16x8, pw[0]), o[1], 0, 0, 0); pw[2][1] = cvtpk(pb[2], pb[3]); EXP2(s0, pa, 2); SB();
        F0 = FLOAD(12); o[2] = __builtin_amdgcn_mfma_f32_32x32x16_bf16(F1, __builtin_bit_cast(bf16x8, pw[0]), o[2], 0, 0, 0); pw[2][2] = cvtpk(pb[4], pb[5]); EXP2(s0, pa, 4); SB();
        F1 = FLOAD(13); o[3] = __builtin_amdgcn_mfma_f32_32x32x16_bf16(F2, __builtin_bit_cast(bf16x8, pw[0]), o[3], 0, 0, 0); pw[2][3] = cvtpk(pb[6], pb[7]); EXP2(s0, pa, 6); SB();
        F2 = FLOAD(14); o[0] = __builtin_amdgcn_mfma_f32_32x32x16_bf16(F0, __builtin_bit_cast(bf16x8, pw[1]), o[0], 0, 0, 0); pw[3][0] = cvtpk(pb[8], pb[9]); EXP2(s0, pa, 8); SB();
        F0 = FLOAD(15); o[1] = __builtin_amdgcn_mfma_f32_32x32x16_bf16(F1, __builtin_bit_cast(bf16x8, pw[1]), o[1], 0, 0, 0); pw[3][1] = cvtpk(pb[10], pb[11]); EXP2(s0, pa, 10); SB();
        F1 = FLOAD(16); o[2] = __builtin_amdgcn_mfma_f32_32x32x16_bf16(F2, __builtin_bit_cast(bf16x8, pw[1]), o[2], 0, 0, 0); pw[3][2] = cvtpk(pb[12], pb[13]); EXP2(s0, pa, 12); SB();
        F2 = FLOAD(17); o[3] = __builtin_amdgcn_mfma_f32_32x32x16_bf16(F0, __builtin_bit_cast(bf16x8, pw[1]), o[3], 0, 0, 0); pw[3][3] = cvtpk(pb[14], pb[15]); EXP2(s0, pa, 14); SB();
        F0 = FLOAD(18); o[0] = __builtin_amdgcn_mfma_f32_32x32x16_bf16(F1, __builtin_bit_cast(bf16x8, pw[2]), o[0], 0, 0, 0); EXP2(s1, pb, 0); SB();
        F1 = FLOAD(19); o[1] = __builtin_amdgcn_mfma_f32_32x32x16_bf16(F2, __builtin_bit_cast(bf16x8, pw[2]), o[1], 0, 0, 0); EXP2(s1, pb, 2); SB();
        F2 = FLOAD(20); o[2] = __builtin_amdgcn_mfma_f32_32x32x16_bf16(F0, __builtin_bit_cast(bf16x8, pw[2]), o[2], 0, 0, 0); EXP2(s1, pb, 4); SB();
        F0 = FLOAD(21); o[3] = __builtin_amdgcn_mfma_f32_32x32x16_bf16(F1, __builtin_bit_cast(bf16x8, pw[2]), o[3], 0, 0, 0); EXP2(s1, pb, 6); SB();
        F1 = FLOAD(22); o[0] = __builtin_amdgcn_mfma_f32_32x32x16_bf16(F2, __builtin_bit_cast(bf16x8, pw[3]), o[0], 0, 0, 0); EXP2(s1, pb, 8); SB();
        F2 = FLOAD(23); o[1] = __builtin_amdgcn_mfma_f32_32x32x16_bf16(F0, __builtin_bit_cast(bf16x8, pw[3]), o[1], 0, 0, 0); EXP2(s1, pb, 10); SB();
        o[2] = __builtin_amdgcn_mfma_f32_32x32x16_bf16(F1, __builtin_bit_cast(bf16x8, pw[3]), o[2], 0, 0, 0); EXP2(s1, pb, 12); SB();
        o[3] = __builtin_amdgcn_mfma_f32_32x32x16_bf16(F2, __builtin_bit_cast(bf16x8, pw[3]), o[3], 0, 0, 0); EXP2(s1, pb, 14); SB();
#undef ADD4
#undef EXP2
#undef FADDR
#undef FLOAD
        asm volatile("s_waitcnt vmcnt(0) lgkmcnt(0)" ::: "memory");
        __builtin_amdgcn_s_barrier();
        const int tmp = bV; bV = bK; bK = bW; bW = tmp;
    }
    {
        float a0 = 0.f, a1 = 0.f;
#pragma unroll
        for (int r = 0; r < 16; ++r) { a0 += pa[r]; a1 += pb[r]; }
        l0 += a0; l1 += a1;
        pw[0] = (u32x4){cvtpk(pa[0], pa[1]), cvtpk(pa[2], pa[3]), cvtpk(pa[4], pa[5]), cvtpk(pa[6], pa[7])};
        pw[1] = (u32x4){cvtpk(pa[8], pa[9]), cvtpk(pa[10], pa[11]), cvtpk(pa[12], pa[13]), cvtpk(pa[14], pa[15])};
        pw[2] = (u32x4){cvtpk(pb[0], pb[1]), cvtpk(pb[2], pb[3]), cvtpk(pb[4], pb[5]), cvtpk(pb[6], pb[7])};
        pw[3] = (u32x4){cvtpk(pb[8], pb[9]), cvtpk(pb[10], pb[11]), cvtpk(pb[12], pb[13]), cvtpk(pb[14], pb[15])};
#pragma unroll
        for (int j = 0; j < 4; ++j)
#pragma unroll
            for (int b = 0; b < 4; ++b) o[b] = __builtin_amdgcn_mfma_f32_32x32x16_bf16(VFR(bV, j, b), __builtin_bit_cast(bf16x8, pw[j]), o[b], 0, 0, 0);
    }
    float l = l0 + l1;
#undef AT_DMA
#undef AT_ADV
#undef SB
#undef KFR
#undef VFR
    asm volatile("s_waitcnt vmcnt(0) lgkmcnt(0)" ::: "memory");
    __builtin_amdgcn_s_barrier();
    l += __shfl_xor(l, 32);
    const float inv = 1.0f / l;
    LAS float* xw = (LAS float*)(lds + AT_XOFF + wq * 16384);
    if (map == 1) {
        const float f = inv * lam;
#pragma unroll
        for (int b = 0; b < 4; ++b)
#pragma unroll
            for (int r = 0; r < 16; ++r) xw[(b * 16 + r) * 64 + lane] = o[b][r] * f;
    }
    __syncthreads();
    if (map == 0) {
        float ss = 0.f;
#pragma unroll
        for (int b = 0; b < 4; ++b)
#pragma unroll
            for (int r = 0; r < 16; ++r) { const float v = o[b][r] * inv - xw[(b * 16 + r) * 64 + lane]; o[b][r] = v; ss += v * v; }
        ss += __shfl_xor(ss, 32);
        const float rs = __builtin_amdgcn_rsqf(ss * (1.0f / VD) + EPS) * (1.0f - LAM_INIT);
        LAS unsigned char* stg = (LAS unsigned char*)xw;
#pragma unroll
        for (int b = 0; b < 4; ++b)
#pragma unroll
            for (int r4 = 0; r4 < 4; ++r4) {
                const int dv = 32 * b + 8 * r4 + 4 * hi;
                const f32x4 sg = *(const f32x4*)(sub_g + dv);
                u32x2 w; w.x = cvtpk(o[b][4 * r4 + 0] * rs * sg[0], o[b][4 * r4 + 1] * rs * sg[1]); w.y = cvtpk(o[b][4 * r4 + 2] * rs * sg[2], o[b][4 * r4 + 3] * rs * sg[3]);
                *(LAS u32x2*)(stg + r32 * 272 + dv * 2) = w;
            }
        asm volatile("s_waitcnt lgkmcnt(0)" ::: "memory");
        const bf16_t* GA = (const bf16_t*)(ws + WS_GA); bf16_t* MIX = (bf16_t*)(ws + WS_MIX);
        u32x4 gvs[8];
#pragma unroll
        for (int i = 0; i < 8; ++i) gvs[i] = *(const u32x4*)(GA + (size_t)(qrow0 + (lane >> 4) + 4 * i) * 1024 + h * 128 + (lane & 15) * 8);
#pragma unroll
        for (int i = 0; i < 8; ++i) {
            const int q = (lane >> 4) + 4 * i, ch = lane & 15;
            const u32x4 ov = *(const LAS u32x4*)(stg + q * 272 + ch * 16);
            const size_t tok = (size_t)(qrow0 + q);
            const u32x4 gv = gvs[i];
            u32x4 w;
            w.x = cvtpk(bf_lo(ov.x) * bf_lo(gv.x), bf_hi(ov.x) * bf_hi(gv.x)); w.y = cvtpk(bf_lo(ov.y) * bf_lo(gv.y), bf_hi(ov.y) * bf_hi(gv.y));
            w.z = cvtpk(bf_lo(ov.z) * bf_lo(gv.z), bf_hi(ov.z) * bf_hi(gv.z)); w.w = cvtpk(bf_lo(ov.w) * bf_lo(gv.w), bf_hi(ov.w) * bf_hi(gv.w));
            *(u32x4*)(MIX + tok * DM + h * 128 + ch * 8) = w;
        }
    }
    __syncthreads();
}

__device__ __forceinline__ void conv_unit(unsigned char* ws, LAS unsigned char* lds, int t0) {
    const int tid = threadIdx.x, lane = tid & 63, wid = tid >> 6, c0 = 2 * tid;
    const float* conv_w = KIN(I_CONVW); const float* conv_b = KIN(I_CONVB);
    const bf16_t* Y = (const bf16_t*)(ws + WS_Y);
    float y0[62], y1[62];
#pragma unroll
    for (int r = 0; r < 62; ++r) {
        const int row = t0 - 15 + r;
        unsigned yv = 0u;
        if (row >= 0 && row < SEQ) yv = *(const unsigned*)(Y + (size_t)row * CONVW + c0);
        y0[r] = bf_lo(yv); y1[r] = bf_hi(yv);
    }
    const f32x2 bias = *(const f32x2*)(conv_b + c0);
    float a0[32], a1[32];
#pragma unroll
    for (int t = 0; t < 32; ++t) { a0[t] = bias[0]; a1[t] = bias[1]; }
#pragma unroll
    for (int j = 0; j < CONVK; ++j) {
        const f32x2 w = *(const f32x2*)(conv_w + j * CONVW + c0);
#pragma unroll
        for (int t = 0; t < 32; ++t) { a0[t] += w[0] * y0[t + j]; a1[t] += w[1] * y1[t + j]; }
    }
    const bf16_t* GC = (const bf16_t*)(ws + WS_GC);
    unsigned gcv[32];
#pragma unroll
    for (int t = 0; t < 32; ++t) gcv[t] = *(const unsigned*)(GC + (size_t)(t0 + t) * CONVW + c0);
    float v[64];
#pragma unroll
    for (int t = 0; t < 32; ++t) { v[t] = a0[t] + a1[t]; v[32 + t] = a0[t] * a0[t] + a1[t] * a1[t]; }
#pragma unroll
    for (int h = 32; h >= 1; h >>= 1) {
        const bool up = (lane & h) != 0;
#pragma unroll
        for (int i = 0; i < h; ++i) {
            const float send = up ? v[i] : v[i + h], keep = up ? v[i + h] : v[i];
            v[i] = keep + __shfl_xor(send, h);
        }
    }
    LAS float* red = (LAS float*)lds;
    LAS float* stat = red + 512;
    red[wid * 64 + lane] = v[0];
    __syncthreads();
    if (tid < 32) {
        float s1 = 0.f, s2 = 0.f;
#pragma unroll
        for (int w = 0; w < 8; ++w) { s1 += red[w * 64 + tid]; s2 += red[w * 64 + 32 + tid]; }
        const float mean = s1 * (1.0f / CONVW), var = fmaxf(s2 * (1.0f / CONVW) - mean * mean, 0.f);
        stat[tid * 2] = mean; stat[tid * 2 + 1] = __builtin_amdgcn_rsqf(var + EPS);
    }
    __syncthreads();
    const float* ln_g = KIN(I_LNG); const float* ln_b = KIN(I_LNB);
    bf16_t* MIX = (bf16_t*)(ws + WS_MIX);
    const f32x2 lg = *(const f32x2*)(ln_g + c0), lb = *(const f32x2*)(ln_b + c0);
#pragma unroll
    for (int t = 0; t < 32; ++t) {
        const float mean = stat[t * 2], rstd = stat[t * 2 + 1];
        const float v0 = (a0[t] - mean) * rstd * lg[0] + lb[0], v1 = (a1[t] - mean) * rstd * lg[1] + lb[1];
        const unsigned gc = gcv[t];
        *(unsigned*)(MIX + (size_t)(t0 + t) * DM + ATTW + c0) = cvtpk(silu_f(v0) * bf_lo(gc), silu_f(v1) * bf_hi(gc));
    }
    __syncthreads();
}

#define XB_TMO      128
#define XB_XCNT(j)  (256  + 64 * (j))
#define XB_XSUB(j)  (1280 + 64 * (j))
#define XB_XGEN(j)  (2304 + 64 * (j))
#define XB_TOP      3328
#define XB_TOPGEN   3392
#define XCD_BAR_WORDS 3456
#define XB_SPIN_CAP (1u << 18)
__device__ __forceinline__ unsigned xb_ld(unsigned* p)              { return __hip_atomic_load(p, __ATOMIC_RELAXED, __HIP_MEMORY_SCOPE_AGENT); }
__device__ __forceinline__ unsigned xb_add(unsigned* p, unsigned v) { return __hip_atomic_fetch_add(p, v, __ATOMIC_RELAXED, __HIP_MEMORY_SCOPE_AGENT); }
__device__ __forceinline__ unsigned xb_xcc_id() { return (unsigned)__builtin_amdgcn_s_getreg((3 << 11) | 20) & 0xFu; }
#define XB_SPIN(cond, bar) do { unsigned _sp = 0; while (cond) { __builtin_amdgcn_s_sleep(1); \
    if ((++_sp & 255u) == 0u) { if (xb_ld(&(bar)[XB_TMO])) break; if (_sp > XB_SPIN_CAP) { atomicAdd(&(bar)[XB_TMO], 1u); break; } } } } while (0)
struct XcdBarrier { unsigned* bar; unsigned x; volatile LAS unsigned* st; };
__device__ __forceinline__ XcdBarrier xcd_barrier_post(unsigned* bar, volatile LAS unsigned* st) {
    XcdBarrier b; b.bar = bar; b.x = xb_xcc_id(); b.st = st;
    if (threadIdx.x == 0) st[3] = xb_add(&bar[XB_XCNT(b.x)], 1u);
    return b;
}
__device__ __forceinline__ void xcd_barrier_complete(unsigned* bar, unsigned x, unsigned& nloc, unsigned& nx, unsigned& uni) {
    const unsigned G = gridDim.x * gridDim.y * gridDim.z;
    unsigned sum, cnt, mine, sp = 0u, ok32;
    for (;;) {
        sum = 0u; cnt = 0u; mine = 0u; ok32 = 1u;
#pragma unroll
        for (unsigned j = 0; j < 16; ++j) { const unsigned c = xb_ld(&bar[XB_XCNT(j)]); sum += c; cnt += (c > 0u) ? 1u : 0u; mine = (j == x) ? c : mine; ok32 &= (c == ((j < 8u) ? 32u : 0u)) ? 1u : 0u; }
        if (sum == G) break;
        __builtin_amdgcn_s_sleep(1);
        if ((++sp & 255u) == 0u) { if (xb_ld(&bar[XB_TMO])) break; if (sp > XB_SPIN_CAP) { atomicAdd(&bar[XB_TMO], 1u); break; } }
    }
    nloc = mine > 0u ? mine : 1u; nx = cnt > 0u ? cnt : 1u; uni = (sum == G && G == 256u) ? ok32 : 0u;
}
__device__ __forceinline__ void xcd_barrier(const XcdBarrier& b) {
    asm volatile("s_waitcnt vmcnt(0)" ::: "memory");
    __syncthreads();
    if (threadIdx.x == 0) {
        unsigned* bar = b.bar;
        __builtin_amdgcn_s_waitcnt(0);
        unsigned nloc = b.st[0], nx = b.st[1];
        if (nloc == 0u) { unsigned uni; xcd_barrier_complete(bar, b.x, nloc, nx, uni); b.st[0] = nloc; b.st[1] = nx; b.st[2] = uni; }
        const unsigned old = xb_add(&bar[XB_XSUB(b.x)], 1u);
        const unsigned gen = old / nloc;
        if (old + 1u == (gen + 1u) * nloc) {
            __builtin_amdgcn_fence(__ATOMIC_RELEASE, "agent");
            asm volatile("s_waitcnt vmcnt(0)" ::: "memory");
            const unsigned og = xb_add(&bar[XB_TOP], 1u);
            const unsigned tg = og / nx;
            if (og + 1u == (tg + 1u) * nx) xb_add(&bar[XB_TOPGEN], 1u);
            else XB_SPIN(xb_ld(&bar[XB_TOPGEN]) == tg, bar);
            __builtin_amdgcn_fence(__ATOMIC_ACQUIRE, "agent");
            xb_add(&bar[XB_XGEN(b.x)], 1u);
            asm volatile("s_waitcnt vmcnt(0)" ::: "memory");
        } else {
            XB_SPIN(xb_ld(&bar[XB_XGEN(b.x)]) == gen, bar);
            __builtin_amdgcn_fence(__ATOMIC_ACQUIRE, "agent");
            asm volatile("s_waitcnt vmcnt(0)" ::: "memory");
        }
    }
    __syncthreads();
}

__global__ void __launch_bounds__(512, 2) fwd_kernel(Args args) {
    extern __shared__ __attribute__((aligned(16))) unsigned char lds_raw[];
    LAS unsigned char* lds = (LAS unsigned char*)lds_raw;
    cg::grid_group grid = cg::this_grid();
    const int tid = threadIdx.x, lane = tid & 63, wave = __builtin_amdgcn_readfirstlane(tid >> 6);
    const int G = gridDim.x, bx = blockIdx.x;
    const int gw = bx * 8 + wave, NGW = G * 8;
    const int lo = args.ph_lo, hi = args.ph_hi;
#define IN(k) (lo <= (k) && (k) < hi)
#define BOTH(k) (IN(k) && IN((k) + 1))
    volatile LAS unsigned* bst = (volatile LAS unsigned*)(lds + LDS_BYTES - 64);
    if (tid < 16) bst[tid] = 0u;
    __syncthreads();
    const XcdBarrier gbar = xcd_barrier_post((unsigned*)(KWS + WS_BAR), bst);
    if (lo > 1000) grid.sync();
#define GRID_SYNC() xcd_barrier(gbar)

    if (IN(0)) { phase0(lds, bx, G, lane, wave); __syncthreads(); }
    if (IN(1)) { phase1(lds, gw, NGW, lane, wave); if (BOTH(1)) GRID_SYNC(); }
    int vb = bx;
    if (BOTH(1) && bst[2] != 0u) vb = __builtin_amdgcn_readfirstlane((int)(bst[3] * 8u + gbar.x));
    const bool split2 = (G == 256) && (hi - lo == 5);
    if (IN(2)) {
        EpiIn E;
        if (split2) {
            { SchedIn S{(const char*)KWS, vb, G, 0, 768}; pg8::gemm_phase<EpiIn, SchedIn>(lds, S, E); }
            GRID_SYNC();
            if (vb < 136) { SchedIn S{(const char*)KWS, vb, G, 768, 904}; pg8::gemm_phase<EpiIn, SchedIn>(lds, S, E); }
            else {
                const int j = vb - 136;
                unsigned char* ws = KWS;
                for (int cu = j; cu < SEQ / 32; cu += 120) conv_unit(ws, lds, 32 * cu);
                if (j >= 16) {
                    LAS float* scr = (LAS float*)(lds + wave * 16640);
                    const float* w_out = KIN(I_WOUT); bf16_t* WO = (bf16_t*)(ws + WS_WO);
                    for (int it = (j - 16) * 8 + wave; it < 32 * (DM / 64); it += 104 * 8) { const int kb = it / (DM / 64), nb = it % (DM / 64); transpose_item(w_out, DM, WO, kb * 64, nb * 64, false, scr, lane); }
                }
            }
        } else {
            SchedIn S{(const char*)KWS, vb, G, 0, 904};
            pg8::gemm_phase<EpiIn, SchedIn>(lds, S, E);
            if (G == 256 && vb >= 136) {
                LAS float* scr = (LAS float*)(lds + wave * 16640);
                const float* w_out = KIN(I_WOUT); bf16_t* WO = (bf16_t*)(KWS + WS_WO);
                for (int it = (vb - 136) * 8 + wave; it < 32 * (DM / 64); it += 120 * 8) { const int kb = it / (DM / 64), nb = it % (DM / 64); transpose_item(w_out, DM, WO, kb * 64, nb * 64, false, scr, lane); }
            }
        }
        if (BOTH(2)) GRID_SYNC();
    }
    if (IN(3)) {
        const float* lq1 = KIN(I_LQ1); const float* lk1 = KIN(I_LK1); const float* lq2 = KIN(I_LQ2); const float* lk2 = KIN(I_LK2);
        const float d1 = wave_sum(lq1[lane] * lk1[lane]), d2 = wave_sum(lq2[lane] * lk2[lane]);
        const float lam = __expf(d1) - __expf(d2) + LAM_INIT;
        const float* qg = KIN(I_QG); const float* kg = KIN(I_KG);
        const float mq = wave_max(fabsf(qg[lane])), mk = wave_max(fabsf(kg[lane]));
        const float negM = -(QSCALE * 64.0f * mq * mk * 1.01f);
        unsigned char* ws = KWS;
        if (!split2) for (int t0 = vb * 32; t0 < SEQ; t0 += G * 32) conv_unit(ws, lds, t0);
        const float* sub_g = KIN(I_SUBG);
        for (int u = vb; u < NH * (SEQ / 128); u += G) attn_unit(ws, sub_g, lds, u & 7, u >> 3, negM, lam);
        if (BOTH(3)) GRID_SYNC();
    }
    if (IN(4)) {
        SchedOut S{(const char*)KWS, vb, G};
        EpiOut E;
        pg8::gemm_phase<EpiOut, SchedOut>(lds, S, E);
    }
#undef IN
#undef BOTH
}

extern "C" void kernel_launch(void* const* d_in, const int* in_sizes, int n_in, void* d_out, int out_size, void* d_ws, size_t ws_size, hipStream_t stream) {
    static int grid = 0;
    if (grid == 0) {
        if (n_in != 20 || out_size != SEQ * DM || ws_size < WS_END) { fprintf(stderr, "kernel_launch: unexpected shapes (n_in %d out %d ws %zu)\n", n_in, out_size, ws_size); grid = -1; return; }
        int dev = 0, cus = 0, per_cu = 0;
        if (hipGetDevice(&dev) != hipSuccess || hipDeviceGetAttribute(&cus, hipDeviceAttributeMultiprocessorCount, dev) != hipSuccess) { grid = -1; return; }
        if (hipFuncSetAttribute((const void*)fwd_kernel, hipFuncAttributeMaxDynamicSharedMemorySize, LDS_BYTES) != hipSuccess) { fprintf(stderr, "kernel_launch: hipFuncSetAttribute failed\n"); grid = -1; return; }
        if (hipOccupancyMaxActiveBlocksPerMultiprocessor(&per_cu, (const void*)fwd_kernel, 512, LDS_BYTES) != hipSuccess || per_cu < 1) { fprintf(stderr, "kernel_launch: occupancy query gave %d\n", per_cu); per_cu = 1; }
        (void)hipGetLastError();
        grid = cus * 1;
    }
    if (grid < 0) return;
    (void)hipMemsetAsync((char*)d_ws + WS_MOD, 0, WS_ZERO_BYTES, stream);
    Args a{};
    for (int i = 0; i < 20; ++i) a.in[i] = (const float*)d_in[i];
    a.out = (float*)d_out; a.ws = (unsigned char*)d_ws;
#if MK_N_LAUNCHES == 1
    a.ph_lo = 0; a.ph_hi = 5;
    void* kargs[] = {&a};
    hipError_t e = hipLaunchCooperativeKernel((const void*)fwd_kernel, dim3(grid), dim3(512), kargs, LDS_BYTES, stream);
    if (e != hipSuccess) {
        fprintf(stderr, "cooperative launch failed: %s (grid %d); falling back to one launch per phase\n", hipGetErrorString(e), grid);
        (void)hipGetLastError();
        for (int ph = 0; ph < 5; ++ph) { a.ph_lo = ph; a.ph_hi = ph + 1; hipLaunchKernelGGL(fwd_kernel, dim3(grid), dim3(512), LDS_BYTES, stream, a); }
    }
#else
    for (int ph = 0; ph < 5; ++ph) {
        a.ph_lo = ph; a.ph_hi = ph + 1;
        hipLaunchKernelGGL(fwd_kernel, dim3(grid), dim3(512), LDS_BYTES, stream, a);
    }
#endif
}
```

```cpp
#include <hip/hip_runtime.h>
#include <hip/hip_cooperative_groups.h>
#include <cstdio>
#include <cstdint>
namespace cg = cooperative_groups;

#ifndef MK_N_LAUNCHES
#define MK_N_LAUNCHES 1
#endif

#define LAS __attribute__((address_space(3)))
typedef unsigned short bf16_t;
typedef short bf16x8 __attribute__((ext_vector_type(8)));
typedef float f32x2 __attribute__((ext_vector_type(2)));
typedef float f32x4 __attribute__((ext_vector_type(4)));
typedef float f32x16 __attribute__((ext_vector_type(16)));
typedef unsigned u32x2 __attribute__((ext_vector_type(2)));
typedef unsigned u32x4 __attribute__((ext_vector_type(4)));
typedef __bf16 bf16x2_t __attribute__((ext_vector_type(2)));

constexpr int DM = 2048, SEQ = 8192, CTXL = 256, NTOK = SEQ + CTXL, INW = 7168;
constexpr int NH = 8, HD = 64, VD = 128, ATTW = 1024, CONVW = 1024, CONVK = 31;
constexpr float EPS = 1e-6f;
constexpr float LOG2E = 1.4426950408889634f;
constexpr float QSCALE = 0.125f * LOG2E;
constexpr float LAM_INIT = 0.2f;

constexpr size_t MiB = 1u << 20;
constexpr size_t WS_MOD = 0;
constexpr size_t WS_BAR = 49152;
constexpr size_t WS_P0CNT = 63488;
constexpr size_t WS_ZERO_BYTES = 65536;
constexpr size_t WS_TAB = 65536;
constexpr size_t WS_WT = 1 * MiB;
constexpr size_t WS_WO = 29 * MiB;
constexpr size_t WS_H = 40 * MiB;
constexpr size_t WS_Q = 74 * MiB;
constexpr size_t WS_K = 90 * MiB;
constexpr size_t WS_VT = 107 * MiB;
constexpr size_t WS_GA = 124 * MiB;
constexpr size_t WS_Y = 140 * MiB;
constexpr size_t WS_GC = 156 * MiB;
constexpr size_t WS_MIX = 172 * MiB;
constexpr size_t WS_END = 204 * MiB;

constexpr int LDS_BYTES = 147456;

__device__ __forceinline__ unsigned cvtpk(float lo, float hi) { f32x2 v = {lo, hi}; bf16x2_t b = __builtin_convertvector(v, bf16x2_t); return __builtin_bit_cast(unsigned, b); }
__device__ __forceinline__ float bf_lo(unsigned u) { return __builtin_bit_cast(float, u << 16); }
__device__ __forceinline__ float bf_hi(unsigned u) { return __builtin_bit_cast(float, u & 0xffff0000u); }
__device__ __forceinline__ float wave_sum(float v) {
#pragma unroll
    for (int o = 1; o < 64; o <<= 1) v += __shfl_xor(v, o);
    return v;
}
__device__ __forceinline__ float wave_max(float v) {
#pragma unroll
    for (int o = 1; o < 64; o <<= 1) v = fmaxf(v, __shfl_xor(v, o));
    return v;
}
__device__ __forceinline__ float silu_f(float v) { return v * __builtin_amdgcn_rcpf(1.0f + __builtin_amdgcn_exp2f(-v * LOG2E)); }
__device__ __forceinline__ float sigmoid_f(float v) { return __builtin_amdgcn_rcpf(1.0f + __builtin_amdgcn_exp2f(-v * LOG2E)); }
__device__ __forceinline__ float fadd_s(float a, float b) { float r; asm("v_add_f32_e32 %0, %1, %2" : "=v"(r) : "v"(a), "v"(b)); return r; }
__device__ __forceinline__ int perm5(int f5) { return 16 * ((f5 >> 2) & 1) + 4 * (f5 >> 3) + (f5 & 3); }

namespace pg8 {
constexpr int BM = 256, BK = 64, HALF = 128, HTB = HALF * BK * 2, STAGE_BYTES = 8 * HTB;
constexpr int GK = 2048;
__device__ __forceinline__ int lds_byte(int r, int c) { const int st = (r >> 4) * 2 + (c >> 5), rr = r & 15, cc = c & 31, ob = rr * 64 + cc * 2; return st * 1024 + (ob ^ (((ob >> 9) & 1) << 5)); }
__device__ __forceinline__ void stage_rc(int b, int& R, int& C) { const int st = b / 1024, sb = b % 1024, swz = sb ^ (((sb >> 9) & 1) << 5); R = (st >> 1) * 16 + swz / 64; C = (st & 1) * 32 + (swz % 64) / 2; }

struct Unit { const char* a; const char* b; int kind, pm, pn; };

template <class Epi, class Sched>
__device__ __forceinline__ void gemm_phase(LAS unsigned char* lds, const Sched& S, const Epi& E) {
    const int tid = threadIdx.x, wid = __builtin_amdgcn_readfirstlane(tid >> 6), lane = tid & 63, wr = wid >> 2, wc = wid & 3, fr = lane & 15, fq = lane >> 4;
    constexpr int K = GK, nt = K / BK;
    unsigned voffA[2];
#pragma unroll
    for (int i = 0; i < 2; ++i) { int R, C; stage_rc(tid * 16 + i * 8192, R, C); voffA[i] = (unsigned)(R * K + C) * 2u; }
    const size_t kstep = (size_t)(BK * 2);
    const size_t hstep = (size_t)HALF * K * 2;
    const unsigned ldsw = (unsigned)wid * 1024u;
    const int aoff = lds_byte(wr * 64 + fr, fq * 8), boff = lds_byte(wc * 32 + fr, fq * 8);
#define PG8_SA(b, h) (((b) * 2 + (h)) * HTB)
#define PG8_SB(b, h) ((4 + (b) * 2 + (h)) * HTB)
#define PG8_STAGE(bufoff, gbase) do { _Pragma("unroll") for (int _i = 0; _i < 2; ++_i) \
        __builtin_amdgcn_global_load_lds((const unsigned*)((const char*)(gbase) + voffA[_i]), (LAS unsigned*)(lds + (bufoff) + ldsw + _i * 8192), 16, 0, 0); } while (0)
#define PG8_LDA(dst, b, h) do { _Pragma("unroll") for (int m = 0; m < 4; ++m) _Pragma("unroll") for (int k = 0; k < 2; ++k) dst[m][k] = *(const LAS bf16x8*)(lds + PG8_SA(b, h) + aoff + m * 2048 + k * 1024); } while (0)
#define PG8_LDB(dst, b, h) do { _Pragma("unroll") for (int n = 0; n < 2; ++n) _Pragma("unroll") for (int k = 0; k < 2; ++k) dst[n][k] = *(const LAS bf16x8*)(lds + PG8_SB(b, h) + boff + n * 2048 + k * 1024); } while (0)
#define PG8_MMA(ai, bj, At, Bt) do { __builtin_amdgcn_s_setprio(1); _Pragma("unroll") for (int m = 0; m < 4; ++m) _Pragma("unroll") for (int n = 0; n < 2; ++n) _Pragma("unroll") for (int k = 0; k < 2; ++k) \
        acc[ai][bj][m][n] = __builtin_amdgcn_mfma_f32_16x16x32_bf16(Bt[n][k], At[m][k], acc[ai][bj][m][n], 0, 0, 0); __builtin_amdgcn_s_setprio(0); } while (0)
#define PG8_WAIT_V(n) asm volatile("s_waitcnt vmcnt(" #n ")" ::: "memory")
#define PG8_WAIT_L(n) asm volatile("s_waitcnt lgkmcnt(" #n ")" ::: "memory")
#define PG8_BAR __builtin_amdgcn_s_barrier()
#define PG8_SCHED __builtin_amdgcn_sched_barrier(0)
    Unit cur, nxt; int ui = 0;
    if (!S.next(0, cur)) return;
    f32x4 acc[2][2][4][2];
#pragma unroll
    for (int a = 0; a < 2; ++a)
#pragma unroll
        for (int b = 0; b < 2; ++b)
#pragma unroll
            for (int m = 0; m < 4; ++m)
#pragma unroll
                for (int n = 0; n < 2; ++n) acc[a][b][m][n] = (f32x4){0.f, 0.f, 0.f, 0.f};
    bf16x8 At[4][2], B0[2][2], B1[2][2];
    const char* cA = cur.a; const char* cB = cur.b;
    PG8_STAGE(PG8_SB(0, 0), cB); PG8_STAGE(PG8_SB(0, 1), cB + hstep); PG8_STAGE(PG8_SA(0, 0), cA); PG8_STAGE(PG8_SA(0, 1), cA + hstep);
    if (wr == 1) PG8_BAR;
    PG8_WAIT_V(2); PG8_BAR;
    PG8_STAGE(PG8_SB(1, 0), cB + kstep); PG8_STAGE(PG8_SA(1, 0), cA + kstep); PG8_STAGE(PG8_SB(1, 1), cB + hstep + kstep);
    PG8_WAIT_V(6); PG8_BAR;
    for (;;) {
        const bool has_next = S.next(ui + 1, nxt);
        const char* nA = has_next ? nxt.a : cA; const char* nB = has_next ? nxt.b : cB;
        for (int t = 0; t < nt; t += 2) {
            const bool last = (t == nt - 2);
            const char* a1 = cA + (size_t)(t + 1) * kstep;
            const char* a2 = last ? nA : cA + (size_t)(t + 2) * kstep; const char* b2 = last ? nB : cB + (size_t)(t + 2) * kstep;
            const char* a3 = a2 + kstep; const char* b3 = b2 + kstep;
            PG8_LDB(B0, 0, 0); PG8_LDB(B1, 0, 1); PG8_SCHED; PG8_LDA(At, 0, 0); PG8_STAGE(PG8_SA(1, 1), a1 + hstep);
            PG8_WAIT_V(8); PG8_WAIT_L(0); PG8_BAR; PG8_MMA(0, 0, At, B0); PG8_MMA(0, 1, At, B1); PG8_BAR; PG8_SCHED;
            PG8_LDA(At, 0, 1); PG8_STAGE(PG8_SB(0, 0), b2); PG8_STAGE(PG8_SB(0, 1), b2 + hstep); PG8_STAGE(PG8_SA(0, 0), a2);
            PG8_WAIT_V(8); PG8_WAIT_L(0); PG8_BAR; PG8_MMA(1, 0, At, B0); PG8_MMA(1, 1, At, B1); PG8_BAR; PG8_SCHED;
            PG8_LDB(B0, 1, 0); PG8_LDB(B1, 1, 1); PG8_SCHED; PG8_LDA(At, 1, 0); PG8_STAGE(PG8_SA(0, 1), a2 + hstep);
            PG8_WAIT_V(8); PG8_WAIT_L(0); PG8_BAR; PG8_MMA(0, 0, At, B0); PG8_MMA(0, 1, At, B1); PG8_BAR; PG8_SCHED;
            PG8_LDA(At, 1, 1); PG8_STAGE(PG8_SB(1, 0), b3); PG8_STAGE(PG8_SB(1, 1), b3 + hstep); PG8_STAGE(PG8_SA(1, 0), a3);
            PG8_WAIT_V(8); PG8_WAIT_L(0); PG8_BAR; PG8_MMA(1, 0, At, B0); PG8_MMA(1, 1, At, B1); PG8_BAR; PG8_SCHED;
        }
        if (wr == 0) PG8_BAR;
        E(acc, cur, wr, wc, fr, fq);
        if (!has_next) break;
#pragma unroll
        for (int a = 0; a < 2; ++a)
#pragma unroll
            for (int b = 0; b < 2; ++b)
#pragma unroll
                for (int m = 0; m < 4; ++m)
#pragma unroll
                    for (int n = 0; n < 2; ++n) acc[a][b][m][n] = (f32x4){0.f, 0.f, 0.f, 0.f};
        cur = nxt; cA = nA; cB = nB; ++ui;
        if (wr == 1) PG8_BAR;
    }
    PG8_WAIT_V(0);
    PG8_BAR;
#undef PG8_SA
#undef PG8_SB
#undef PG8_STAGE
#undef PG8_LDA
#undef PG8_LDB
#undef PG8_MMA
#undef PG8_WAIT_V
#undef PG8_WAIT_L
#undef PG8_BAR
#undef PG8_SCHED
}
}

struct Args { const float* in[20]; float* out; unsigned char* ws; int ph_lo, ph_hi; };
template <int OFF> __device__ __forceinline__ unsigned long long karg64() {
    unsigned long long v;
    asm volatile("s_load_dwordx2 %0, %1, %2\n\ts_waitcnt lgkmcnt(0)" : "=s"(v) : "s"(__builtin_amdgcn_kernarg_segment_ptr()), "n"(OFF) : "memory");
    return v;
}
#define GAS __attribute__((address_space(1)))
#define KIN(i) ((const float*)(GAS const float*)karg64<8 * (i)>())
#define KOUT ((float*)(GAS float*)karg64<160>())
#define KWS ((unsigned char*)(GAS unsigned char*)karg64<168>())
enum { I_X = 0, I_C, I_CTX, I_CCTX, I_WADA, I_BADA, I_NORMG, I_WIN, I_QG, I_KG, I_LQ1, I_LK1, I_LQ2, I_LK2, I_SUBG, I_CONVW, I_CONVB, I_LNG, I_LNB, I_WOUT };

struct SchedIn {
    const char* ws; int c, G, L0, L1;
    __device__ __forceinline__ bool next(int i, pg8::Unit& u) const {
        const int L = L0 + i * G + c; if (L >= L1) return false;
        constexpr size_t RB = (size_t)DM * 2;
        const char* H = ws + WS_H; const char* WT = ws + WS_WT;
        if (L < 768) {
            int wgid = (L % 8) * 96 + L / 8;
            const int gid = wgid / 192, rem = wgid % 192;
            const int pm = gid * 8 + (rem % 8), pn = rem / 8;
            u.a = H + (size_t)(256 + 256 * pm) * RB; u.b = WT + (size_t)(256 * pn) * RB; u.pm = pm; u.pn = pn;
            u.kind = (pn < 8) ? 0 : ((pn >= 12 && pn < 20) ? 2 : 1);
        } else if (L < 900) {
            const int idx = L - 768, pm = idx & 3, pn = idx >> 2;
            u.a = WT + (size_t)(6144 + 256 * pm) * RB; u.b = H + (size_t)(256 * pn) * RB; u.pm = pm; u.pn = pn; u.kind = 3;
        } else {
            const int pn = L - 900;
            u.a = H; u.b = WT + (size_t)(1024 + 256 * pn) * RB; u.pm = 0; u.pn = pn; u.kind = 4;
        }
        return true;
    }
};
struct SchedOut {
    const char* ws; int c, G;
    __device__ __forceinline__ bool next(int i, pg8::Unit& u) const {
        const int L = i * G + c; if (L >= 256) return false;
        constexpr size_t RB = (size_t)DM * 2;
        int wgid = (L % 8) * 32 + L / 8;
        const int gid = wgid / 64, rem = wgid % 64;
        const int pm = gid * 8 + (rem % 8), pn = rem / 8;
        u.a = ws + WS_MIX + (size_t)(256 * pm) * RB; u.b = ws + WS_WO + (size_t)(256 * pn) * RB; u.pm = pm; u.pn = pn; u.kind = 5;
        return true;
    }
};

struct EpiIn {
    __device__ __forceinline__ void operator()(const f32x4 (&acc)[2][2][4][2], const pg8::Unit& u, int wr, int wc, int fr, int fq) const {
        const int kind = u.kind;
        unsigned char* ws = KWS;
        if (kind == 0 || kind == 4) {
            const bool isq = (kind == 0) && (u.pn < 4);
            const float* gsrc = isq ? KIN(I_QG) : KIN(I_KG);
            const float osc = isq ? QSCALE : 1.0f;
            const f32x2* tab = (const f32x2*)(ws + WS_TAB);
            f32x4 g[2][2];
#pragma unroll
            for (int bj = 0; bj < 2; ++bj)
#pragma unroll
                for (int n = 0; n < 2; ++n) g[bj][n] = *(const f32x4*)(gsrc + 32 * bj + 16 * n + 4 * fq);
            bf16_t* dst = (bf16_t*)(ws + (isq ? WS_Q : WS_K));
            const int rowoff = (kind == 0 && !isq) ? CTXL : 0;
            const int G = 4 * (u.pn & 3) + wc;
#pragma unroll
            for (int ai = 0; ai < 2; ++ai) {
                const int rpos = 4 * u.pm + 2 * ai + wr;
                f32x4 cr0, cr1;
                if (kind == 0) { const f32x4* tp = (const f32x4*)(tab + rpos * 16 + 4 * fq); cr0 = tp[0]; cr1 = tp[1]; }
                else { cr0 = (f32x4){1.f, 0.f, 1.f, 0.f}; cr1 = cr0; }
#pragma unroll
                for (int m = 0; m < 4; ++m) {
                    const int t = 256 * u.pm + 128 * ai + 64 * wr + 16 * m + fr;
                    float ss = 0.f;
#pragma unroll
                    for (int bj = 0; bj < 2; ++bj)
#pragma unroll
                        for (int n = 0; n < 2; ++n) { const f32x4 v = acc[ai][bj][m][n]; ss += (v[0] * v[0] + v[1] * v[1]) + (v[2] * v[2] + v[3] * v[3]); }
                    ss += __shfl_xor(ss, 16); ss += __shfl_xor(ss, 32);
                    const float rstd = __builtin_amdgcn_rsqf(ss * (1.0f / 64.0f) + EPS) * osc;
                    f32x4 cc0, cc1;
                    if (kind == 0) { const f32x4* tp = (const f32x4*)(tab + (16 * m + fr) * 16 + 4 * fq); cc0 = tp[0]; cc1 = tp[1]; }
                    else { cc0 = (f32x4){1.f, 0.f, 1.f, 0.f}; cc1 = cc0; }
                    bf16_t* rowp = dst + (size_t)(rowoff + t) * 1024 + G * 64 + 8 * fq;
#pragma unroll
                    for (int bj = 0; bj < 2; ++bj) {
                        const f32x4 x1 = acc[ai][bj][m][0] * g[bj][0] * rstd, x2 = acc[ai][bj][m][1] * g[bj][1] * rstd;
                        const f32x4 ca = bj == 0 ? cr0 : cc0, cb = bj == 0 ? cr1 : cc1;
                        const float co[4] = {ca[0], ca[2], cb[0], cb[2]}, si[4] = {ca[1], ca[3], cb[1], cb[3]};
                        float o1[4], o2[4];
#pragma unroll
                        for (int e = 0; e < 4; ++e) { o1[e] = x1[e] * co[e] - x2[e] * si[e]; o2[e] = x2[e] * co[e] + x1[e] * si[e]; }
                        u32x4 w; w.x = cvtpk(o1[0], o1[1]); w.y = cvtpk(o1[2], o1[3]); w.z = cvtpk(o2[0], o2[1]); w.w = cvtpk(o2[2], o2[3]);
                        *(u32x4*)(rowp + 32 * bj) = w;
                    }
                }
            }
        } else if (kind == 1) {
            const bool isa = u.pn < 12; const int pnl = isa ? (u.pn - 8) : (u.pn - 20);
            bf16_t* dst = (bf16_t*)(ws + (isa ? WS_GA : WS_GC));
#pragma unroll
            for (int ai = 0; ai < 2; ++ai)
#pragma unroll
                for (int m = 0; m < 4; ++m) {
                    const int t = 256 * u.pm + 128 * ai + 64 * wr + 16 * m + fr;
                    bf16_t* rowp = dst + (size_t)t * 1024 + 256 * pnl + 32 * wc + 8 * fq;
#pragma unroll
                    for (int bj = 0; bj < 2; ++bj) {
                        const f32x4 v0 = acc[ai][bj][m][0], v1 = acc[ai][bj][m][1];
                        u32x4 w; w.x = cvtpk(silu_f(v0[0]), silu_f(v0[1])); w.y = cvtpk(silu_f(v0[2]), silu_f(v0[3]));
                        w.z = cvtpk(silu_f(v1[0]), silu_f(v1[1])); w.w = cvtpk(silu_f(v1[2]), silu_f(v1[3]));
                        *(u32x4*)(rowp + 128 * bj) = w;
                    }
                }
        } else if (kind == 2) {
            const int pnl = u.pn - 12;
            bf16_t* Y = (bf16_t*)(ws + WS_Y);
#pragma unroll
            for (int ai = 0; ai < 2; ++ai)
#pragma unroll
                for (int m = 0; m < 4; ++m) {
                    const int t = 256 * u.pm + 128 * ai + 64 * wr + 16 * m + fr;
                    bf16_t* rowp = Y + (size_t)t * 1024 + 128 * pnl + 32 * wc + 8 * fq;
                    const f32x4 a0 = acc[ai][0][m][0], a1 = acc[ai][0][m][1], g0 = acc[ai][1][m][0], g1 = acc[ai][1][m][1];
                    u32x4 w; w.x = cvtpk(a0[0] * sigmoid_f(g0[0]), a0[1] * sigmoid_f(g0[1])); w.y = cvtpk(a0[2] * sigmoid_f(g0[2]), a0[3] * sigmoid_f(g0[3]));
                    w.z = cvtpk(a1[0] * sigmoid_f(g1[0]), a1[1] * sigmoid_f(g1[1])); w.w = cvtpk(a1[2] * sigmoid_f(g1[2]), a1[3] * sigmoid_f(g1[3]));
                    *(u32x4*)rowp = w;
                }
        } else {
            const int sfq = (fq == 1) ? 2 : ((fq == 2) ? 1 : fq);
            bf16_t* VT = (bf16_t*)(ws + WS_VT);
#pragma unroll
            for (int ai = 0; ai < 2; ++ai)
#pragma unroll
                for (int m = 0; m < 4; ++m) {
                    const int f = 256 * u.pm + 128 * ai + 64 * wr + 16 * m + fr;
                    bf16_t* rowp = VT + (size_t)f * NTOK + 256 * u.pn + 32 * wc + 4 * sfq;
#pragma unroll
                    for (int bj = 0; bj < 2; ++bj)
#pragma unroll
                        for (int n = 0; n < 2; ++n) { const f32x4 v = acc[ai][bj][m][n]; u32x2 w; w.x = cvtpk(v[0], v[1]); w.y = cvtpk(v[2], v[3]); *(u32x2*)(rowp + 128 * bj + 16 * n) = w; }
                }
        }
    }
};
struct EpiOut {
    __device__ __forceinline__ void operator()(const f32x4 (&acc)[2][2][4][2], const pg8::Unit& u, int wr, int wc, int fr, int fq) const {
        const float* gate = (const float*)(KWS + WS_MOD) + 4096; const float* gb = KIN(I_BADA) + 4096;
        const float* x = KIN(I_X); float* out = KOUT;
        const int col0 = 256 * u.pn + 32 * wc + 4 * fq;
        f32x4 gv[2][2];
#pragma unroll
        for (int bj = 0; bj < 2; ++bj)
#pragma unroll
            for (int n = 0; n < 2; ++n) gv[bj][n] = *(const f32x4*)(gate + col0 + 128 * bj + 16 * n) + *(const f32x4*)(gb + col0 + 128 * bj + 16 * n);
#pragma unroll
        for (int ai = 0; ai < 2; ++ai)
#pragma unroll
            for (int mh = 0; mh < 2; ++mh) {
                f32x4 xv[2][2][2];
#pragma unroll
                for (int mm = 0; mm < 2; ++mm) {
                    const size_t off = (size_t)(256 * u.pm + 128 * ai + 64 * wr + 16 * (2 * mh + mm) + fr) * DM + col0;
#pragma unroll
                    for (int bj = 0; bj < 2; ++bj)
#pragma unroll
                        for (int n = 0; n < 2; ++n) xv[mm][bj][n] = *(const f32x4*)(x + off + 128 * bj + 16 * n);
                }
#pragma unroll
                for (int mm = 0; mm < 2; ++mm) {
                    const size_t off = (size_t)(256 * u.pm + 128 * ai + 64 * wr + 16 * (2 * mh + mm) + fr) * DM + col0;
#pragma unroll
                    for (int bj = 0; bj < 2; ++bj)
#pragma unroll
                        for (int n = 0; n < 2; ++n) *(f32x4*)(out + off + 128 * bj + 16 * n) = xv[mm][bj][n] + gv[bj][n] * acc[ai][bj][2 * mh + mm][n];
                }
            }
    }
};

__device__ __forceinline__ int win_dest_row(int s) {
    if (s < 2048) { const int base = s & ~1023, ss = s & 1023, G = ss >> 6, d = ss & 63; return base + 256 * (G >> 2) + 128 * (d >> 5) + 32 * (G & 3) + (d & 31); }
    if (s < 3072) return 6144 + (s - 2048);
    if (s < 4096) { const int f = s - 3072; return 2048 + (f & ~31) + perm5(f & 31); }
    if (s < 6144) { const int isg = s >= 5120 ? 1 : 0, ch = s - 4096 - 1024 * isg; return 3072 + 256 * (ch >> 7) + 128 * isg + (ch & 96) + perm5(ch & 31); }
    const int f = s - 6144; return 5120 + (f & ~31) + perm5(f & 31);
}
__device__ __forceinline__ void transpose_item(const float* W, int N, bf16_t* WT, int k0, int n0, bool is_in, LAS float* scr, int lane) {
    const int lr = lane >> 4, lc = (lane & 15) * 4;
    f32x4 v[16];
#pragma unroll
    for (int i = 0; i < 16; ++i) v[i] = __builtin_nontemporal_load((const f32x4*)(W + (size_t)(k0 + 4 * i + lr) * N + n0 + lc));
#pragma unroll
    for (int i = 0; i < 16; ++i) { LAS float* d = scr + (4 * i + lr) * 65 + lc; d[0] = v[i][0]; d[1] = v[i][1]; d[2] = v[i][2]; d[3] = v[i][3]; }
    asm volatile("s_waitcnt lgkmcnt(0)" ::: "memory");
    const int c = lane & 7;
#pragma unroll
    for (int j = 0; j < 8; ++j) {
        const int n = (lane >> 3) + 8 * j; const LAS float* s = scr + (8 * c) * 65 + n;
        u32x4 o; o.x = cvtpk(s[0 * 65], s[1 * 65]); o.y = cvtpk(s[2 * 65], s[3 * 65]); o.z = cvtpk(s[4 * 65], s[5 * 65]); o.w = cvtpk(s[6 * 65], s[7 * 65]);
        const int dr = is_in ? win_dest_row(n0 + n) : (n0 + n);
        *(u32x4*)(WT + (size_t)dr * DM + k0 + 8 * c) = o;
    }
    asm volatile("s_waitcnt lgkmcnt(0)" ::: "memory");
}

__device__ __forceinline__ void phase0(LAS unsigned char* lds, int bx, int G, int lane, int wave) {
    unsigned char* ws = KWS;
    const float* w_ada = KIN(I_WADA); const float* cv = KIN(I_C); const float* ccv = KIN(I_CCTX);
    float* modx = (float*)(ws + WS_MOD);
    LAS float* red = (LAS float*)lds;
    for (int wi = bx; wi < 256; wi += G) {
        const int cc = wi & 31, kb = ((wi >> 5) * 8 + wave) * 32, cb = cc * 192 + lane * 4;
        f32x4 ax = {0.f, 0.f, 0.f, 0.f}, ac = {0.f, 0.f, 0.f, 0.f};
        if (lane < 48) {
#pragma unroll
            for (int k = 0; k < 32; ++k) {
                const f32x4 w = __builtin_nontemporal_load((const f32x4*)(w_ada + (size_t)(kb + k) * 6144 + cb));
                const float sx = silu_f(cv[kb + k]), sc = silu_f(ccv[kb + k]);
                ax += w * sx; ac += w * sc;
            }
            *(LAS f32x4*)(red + (wave * 2 + 0) * 192 + lane * 4) = ax;
            *(LAS f32x4*)(red + (wave * 2 + 1) * 192 + lane * 4) = ac;
        }
        __syncthreads();
        {
            const int t = threadIdx.x;
            if (t < 384) {
                const int vec = t / 192, col = t - vec * 192;
                float s = 0.f;
#pragma unroll
                for (int w = 0; w < 8; ++w) s += red[(w * 2 + vec) * 192 + col];
                unsafeAtomicAdd(modx + vec * 6144 + cc * 192 + col, s);
            }
        }
        __syncthreads();
    }
    asm volatile("s_waitcnt vmcnt(0)" ::: "memory");
    __syncthreads();
    if (threadIdx.x == 0) __hip_atomic_fetch_add((unsigned*)(ws + WS_P0CNT), 1u, __ATOMIC_RELAXED, __HIP_MEMORY_SCOPE_AGENT);
    {
        const int gt = (bx * 8 + wave) * 64 + lane;
        if (gt < 2048) {
            const int p = gt >> 4, f = gt & 15;
            const float inv = exp2f(-(float)f * (13.287712379549449f / 16.0f));
            const float ang = (float)p * inv;
            float rev = ang * 0.15915494309189535f; rev -= floorf(rev);
            ((f32x2*)(ws + WS_TAB))[gt] = (f32x2){__builtin_amdgcn_cosf(rev), __builtin_amdgcn_sinf(rev)};
        }
    }
}

__device__ __forceinline__ void phase1(LAS unsigned char* lds, int gw, int NGW, int lane, int wave) {
    unsigned char* ws = KWS;
    {
        LAS float* scr = (LAS float*)(lds + wave * 16640);
        const float* w_in = KIN(I_WIN); const float* w_out = KIN(I_WOUT);
        bf16_t* WT = (bf16_t*)(ws + WS_WT); bf16_t* WO = (bf16_t*)(ws + WS_WO);
        constexpr int NB_IN = INW / 64, NB_OUT = DM / 64, I_IN = 32 * NB_IN, I_OUT = 32 * NB_OUT;
        const int n_items = (NGW == 2048) ? I_IN : I_IN + I_OUT;
        for (int it = (NGW - 1 - gw); it < n_items; it += NGW) {
            if (it < I_IN) { const int kb = it / NB_IN, nb = it % NB_IN; transpose_item(w_in, INW, WT, kb * 64, nb * 64, true, scr, lane); }
            else { const int r2 = it - I_IN, kb = r2 / NB_OUT, nb = r2 % NB_OUT; transpose_item(w_out, DM, WO, kb * 64, nb * 64, false, scr, lane); }
        }
    }
    if (threadIdx.x == 0) {
        unsigned* cnt = (unsigned*)(ws + WS_P0CNT); const unsigned want = gridDim.x; unsigned spins = 0;
        while (__hip_atomic_load(cnt, __ATOMIC_RELAXED, __HIP_MEMORY_SCOPE_AGENT) < want) { __builtin_amdgcn_s_sleep(2); if (++spins > (1u << 20)) break; }
    }
    __syncthreads();
    const float* x = KIN(I_X); const float* ctx = KIN(I_CTX);
    {
        const float* b_ada = KIN(I_BADA); const float* norm_g = KIN(I_NORMG);
        float* modx = (float*)(ws + WS_MOD); float* modc = modx + 6144;
        const int col = threadIdx.x * 4;
        const f32x4 g = *(const f32x4*)(norm_g + col), bsh = *(const f32x4*)(b_ada + col), bsc = *(const f32x4*)(b_ada + 2048 + col);
        f32x4 sx, hx, sc, hc;
#pragma unroll
        for (int e = 0; e < 4; ++e) {
            sx[e] = __hip_atomic_load(modx + 2048 + col + e, __ATOMIC_RELAXED, __HIP_MEMORY_SCOPE_AGENT); hx[e] = __hip_atomic_load(modx + col + e, __ATOMIC_RELAXED, __HIP_MEMORY_SCOPE_AGENT);
            sc[e] = __hip_atomic_load(modc + 2048 + col + e, __ATOMIC_RELAXED, __HIP_MEMORY_SCOPE_AGENT); hc[e] = __hip_atomic_load(modc + col + e, __ATOMIC_RELAXED, __HIP_MEMORY_SCOPE_AGENT);
        }
        *(LAS f32x4*)(lds + 0 * 8192 + col * 4) = g * (1.0f + sx + bsc);
        *(LAS f32x4*)(lds + 1 * 8192 + col * 4) = hx + bsh;
        *(LAS f32x4*)(lds + 2 * 8192 + col * 4) = g * (1.0f + sc + bsc);
        *(LAS f32x4*)(lds + 3 * 8192 + col * 4) = hc + bsh;
    }
    __syncthreads();
    bf16_t* H = (bf16_t*)(ws + WS_H);
    f32x4 cur[8], nxt[8];
    int r = gw;
    if (r < NTOK) {
        const float* src = (r < CTXL) ? ctx + (size_t)r * DM : x + (size_t)(r - CTXL) * DM;
#pragma unroll
        for (int j = 0; j < 8; ++j) cur[j] = __builtin_nontemporal_load((const f32x4*)(src + (lane + 64 * j) * 4));
    }
    for (; r < NTOK; r += NGW) {
        const int rn = r + NGW;
        if (rn < NTOK) {
            const float* src = (rn < CTXL) ? ctx + (size_t)rn * DM : x + (size_t)(rn - CTXL) * DM;
#pragma unroll
            for (int j = 0; j < 8; ++j) nxt[j] = __builtin_nontemporal_load((const f32x4*)(src + (lane + 64 * j) * 4));
        }
        float ss = 0.f;
#pragma unroll
        for (int j = 0; j < 8; ++j) ss += (cur[j][0] * cur[j][0] + cur[j][1] * cur[j][1]) + (cur[j][2] * cur[j][2] + cur[j][3] * cur[j][3]);
        const float rstd = __builtin_amdgcn_rsqf(wave_sum(ss) * (1.0f / DM) + EPS);
        const int sel = (r < CTXL) ? 2 * 8192 : 0;
        bf16_t* dst = H + (size_t)r * DM;
#pragma unroll
        for (int j = 0; j < 8; ++j) {
            const int col = (lane + 64 * j) * 4;
            const f32x4 ge = *(const LAS f32x4*)(lds + sel + col * 4), sh = *(const LAS f32x4*)(lds + sel + 8192 + col * 4);
            const f32x4 o = cur[j] * rstd * ge + sh;
            u32x2 w; w.x = cvtpk(o[0], o[1]); w.y = cvtpk(o[2], o[3]);
            *(u32x2*)(dst + col) = w;
        }
#pragma unroll
        for (int j = 0; j < 8; ++j) cur[j] = nxt[j];
    }
    __syncthreads();
}

constexpr int AT_KBYTES = 16384, AT_VBYTES = 16384, AT_BUF = AT_KBYTES + AT_VBYTES;
constexpr int AT_XOFF = 0;
constexpr int AT_NT = NTOK / 64;
static_assert(3 * AT_BUF <= LDS_BYTES - 64, "attention ring");

__device__ __forceinline__ void attn_unit(unsigned char* ws, const float* sub_g, LAS unsigned char* lds, int h, int qb, float negM, float lam) {
    const int tid = threadIdx.x, lane = tid & 63, r32 = lane & 31, hi = lane >> 5;
    const int wid = __builtin_amdgcn_readfirstlane(tid >> 6), map = wid >> 2, wq = wid & 3;
    const int qrow0 = qb * 128 + 32 * wq;
    const bf16_t* Qp = (const bf16_t*)(ws + WS_Q); const bf16_t* Kp = (const bf16_t*)(ws + WS_K); const bf16_t* VTp = (const bf16_t*)(ws + WS_VT);
    bf16x8 qf[4];
    {
        const bf16_t* qp = Qp + (size_t)(qrow0 + r32) * 1024 + (h * 2 + map) * 64 + 8 * hi;
#pragma unroll
        for (int d0 = 0; d0 < 4; ++d0) qf[d0] = *(const bf16x8*)(qp + 16 * d0);
    }
    const bf16_t* kg[2]; const bf16_t* vg[2];
#pragma unroll
    for (int i = 0; i < 2; ++i) {
        const int g = 2 * wid + i;
        const int kr = 4 * g + (lane >> 4), kc = (lane & 15) ^ (kr & 15);
        kg[i] = Kp + (size_t)kr * 1024 + h * 128 + kc * 8;
        const int vr = 8 * g + (lane >> 3), vc = (lane & 7) ^ ((vr >> 1) & 7);
        vg[i] = VTp + (size_t)(h * 128 + vr) * NTOK + vc * 8;
    }
    const unsigned dmaoff = (unsigned)wid * 2048u;
#define AT_DMA(B) do { _Pragma("unroll") for (int i_ = 0; i_ < 2; ++i_) { \
        __builtin_amdgcn_global_load_lds((const unsigned*)kg[i_], (LAS unsigned*)(lds + (B) + dmaoff + i_ * 1024), 16, 0, 0); \
        __builtin_amdgcn_global_load_lds((const unsigned*)vg[i_], (LAS unsigned*)(lds + (B) + AT_KBYTES + dmaoff + i_ * 1024), 16, 0, 0); } } while (0)
#define AT_ADV() do { kg[0] += 64 * 1024; kg[1] += 64 * 1024; vg[0] += 64; vg[1] += 64; } while (0)
    int kad[4], vad[4];
#pragma unroll
    for (int d0 = 0; d0 < 4; ++d0) kad[d0] = r32 * 256 + (((map * 8 + 2 * d0 + hi) ^ (r32 & 15)) << 4);
#pragma unroll
    for (int j = 0; j < 4; ++j) vad[j] = AT_KBYTES + r32 * 128 + (((2 * j + hi) ^ ((r32 >> 1) & 7)) << 4);
#define SB() __builtin_amdgcn_sched_barrier(0)
#define KFR(B, d0, kh) (*(const LAS bf16x8*)(lds + (B) + kad[d0] + (kh) * 8192))
#define VFR(B, j, b) (*(const LAS bf16x8*)(lds + (B) + vad[j] + (b) * 4096))
    f32x16 o[4];
#pragma unroll
    for (int b = 0; b < 4; ++b)
#pragma unroll
        for (int r = 0; r < 16; ++r) o[b][r] = 0.f;
    f32x16 negm;
#pragma unroll
    for (int r = 0; r < 16; ++r) negm[r] = negM;
    float l0 = 0.f, l1 = 0.f;
    AT_DMA(0); AT_ADV();
    asm volatile("s_waitcnt vmcnt(0)" ::: "memory");
    __builtin_amdgcn_s_barrier();
    AT_DMA(AT_BUF); AT_ADV();
    f32x16 pa, pb;
    {
        f32x16 s0 = negm, s1 = negm;
#pragma unroll
        for (int d0 = 0; d0 < 4; ++d0) { s0 = __builtin_amdgcn_mfma_f32_32x32x16_bf16(KFR(0, d0, 0), qf[d0], s0, 0, 0, 0); s1 = __builtin_amdgcn_mfma_f32_32x32x16_bf16(KFR(0, d0, 1), qf[d0], s1, 0, 0, 0); }
#pragma unroll
        for (int r = 0; r < 16; ++r) { pa[r] = __builtin_amdgcn_exp2f(s0[r]); pb[r] = __builtin_amdgcn_exp2f(s1[r]); }
    }
    asm volatile("s_waitcnt vmcnt(0) lgkmcnt(0)" ::: "memory");
    __builtin_amdgcn_s_barrier();
    int bV = 0, bK = AT_BUF, bW = 2 * AT_BUF;
    u32x4 pw[4];
    for (int t = 1; t < AT_NT; ++t) {
        AT_DMA(bW);
        if (t + 2 < AT_NT) AT_ADV();
        SB();
#define FADDR(i) (((i) < 8) ? (bK + kad[(i) >> 1] + ((i) & 1) * 8192) : (bV + vad[((i) - 8) >> 2] + (((i) - 8) & 3) * 4096))
#define FLOAD(i) (*(const LAS bf16x8*)(lds + FADDR(i)))
#define ADD4(P, base) do { l0 = fadd_s(l0, P[base]); l1 = fadd_s(l1, P[base + 1]); l0 = fadd_s(l0, P[base + 2]); l1 = fadd_s(l1, P[base + 3]); } while (0)
#define EXP2(S, P, base) do { P[base] = __builtin_amdgcn_exp2f(S[base]); P[base + 1] = __builtin_amdgcn_exp2f(S[base + 1]); } while (0)
        f32x16 s0, s1;
        bf16x8 F0 = FLOAD(0), F1 = FLOAD(1), F2;
        SB();
        F2 = FLOAD(2); s0 = __builtin_amdgcn_mfma_f32_32x32x16_bf16(F0, qf[0], negm, 0, 0, 0); ADD4(pa, 0); pw[0][0] = cvtpk(pa[0], pa[1]); SB();
        F0 = FLOAD(3); s1 = __builtin_amdgcn_mfma_f32_32x32x16_bf16(F1, qf[0], negm, 0, 0, 0); ADD4(pa, 4); pw[0][1] = cvtpk(pa[2], pa[3]); SB();
        F1 = FLOAD(4); s0 = __builtin_amdgcn_mfma_f32_32x32x16_bf16(F2, qf[1], s0, 0, 0, 0); ADD4(pa, 8); pw[0][2] = cvtpk(pa[4], pa[5]); SB();
        F2 = FLOAD(5); s1 = __builtin_amdgcn_mfma_f32_32x32x16_bf16(F0, qf[1], s1, 0, 0, 0); ADD4(pa, 12); pw[0][3] = cvtpk(pa[6], pa[7]); SB();
        F0 = FLOAD(6); s0 = __builtin_amdgcn_mfma_f32_32x32x16_bf16(F1, qf[2], s0, 0, 0, 0); ADD4(pb, 0); pw[1][0] = cvtpk(pa[8], pa[9]); SB();
        F1 = FLOAD(7); s1 = __builtin_amdgcn_mfma_f32_32x32x16_bf16(F2, qf[2], s1, 0, 0, 0); ADD4(pb, 4); pw[1][1] = cvtpk(pa[10], pa[11]); SB();
        F2 = FLOAD(8); s0 = __builtin_amdgcn_mfma_f32_32x32x16_bf16(F0, qf[3], s0, 0, 0, 0); ADD4(pb, 8); pw[1][2] = cvtpk(pa[12], pa[13]); SB();
        F0 = FLOAD(9); s1 = __builtin_amdgcn_mfma_f32_32x32x16_bf16(F1, qf[3], s1, 0, 0, 0); ADD4(pb, 12); pw[1][3] = cvtpk(pa[14], pa[15]); SB();
        F1 = FLOAD(10); o[0] = __builtin_amdgcn_mfma_f32_32x32x16_bf16(F2, __builtin_bit_cast(bf16x8, pw[0]), o[0], 0, 0, 0); pw[2][0] = cvtpk(pb[0], pb[1]); EXP2(s0, pa, 0); SB();
        F2 = FLOAD(11); o[1] = __builtin_amdgcn_mfma_f32_32x32x16_bf16(F0, __builtin_bit_cast(bf16x8, pw[0]), o[1], 0, 0, 0); pw[2][1] = cvtpk(pb[2], pb[3]); EXP2(s0, pa, 2); SB();
        F0 = FLOAD(12); o[2] = __builtin_amdgcn_mfma_f32_32x32x16_bf16(F1, __builtin_bit_cast(bf16x8, pw[0]), o[2], 0, 0, 0); pw[2][2] = cvtpk(pb[4], pb[5]); EXP2(s0, pa, 4); SB();
        F1 = FLOAD(13); o[3] = __builtin_amdgcn_mfma_f32_32x32x16_bf16(F2, __builtin_bit_cast(bf16x8, pw[0]), o[3], 0, 0, 0); pw[2][3] = cvtpk(pb[6], pb[7]); EXP2(s0, pa, 6); SB();
        F2 = FLOAD(14); o[0] = __builtin_amdgcn_mfma_f32_32x32x16_bf16(F0, __builtin_bit_cast(bf16x8, pw[1]), o[0], 0, 0, 0); pw[3][0] = cvtpk(pb[8], pb[9]); EXP2(s0, pa, 8); SB();
        F0 = FLOAD(15); o[1] = __builtin_amdgcn_mfma_f32_32x32x16_bf16(F1, __builtin_bit_cast(bf16x8, pw[1]), o[1], 0, 0, 0); pw[3][1] = cvtpk(pb[10], pb[11]); EXP2(s0, pa, 10); SB();
        F1 = FLOAD(16); o[2] = __builtin_amdgcn_mfma_f32_32x32x16_bf16(F2, __builtin_bit_cast(bf16x8, pw[1]), o[2], 0, 0, 0); pw[3][2] = cvtpk(pb[12], pb[13]); EXP2(s0, pa, 12); SB();
        F2 = FLOAD(17); o[3] = __builtin_amdgcn_mfma_f32_32x32x16_bf16(F0, __builtin_bit_cast(bf16x8, pw[1]), o[3], 0, 0, 0); pw[3][3] = cvtpk(pb[14], pb[15]); EXP2(s0, pa, 14); SB();
        F0 = FLOAD(18); o[0] = __builtin_amdgcn_mfma_f32_32x32x16_bf16(F1, __builtin_bit_cast(bf16x8, pw[2]), o[0], 0, 0, 0); EXP2(s1, pb, 0); SB();
        F1 = FLOAD(19); o[1] = __builtin_amdgcn_mfma_f32_32x32x16_bf16(F2, __builtin_bit_cast(bf16x8, pw[2]), o[1], 0, 0, 0); EXP2(s1, pb, 2); SB();
        F2 = FLOAD(20); o[2] = __builtin_amdgcn_mfma_f32_32x32x16_bf16(F0, __builtin_bit_cast(bf16x8, pw[2]), o[2], 0, 0, 0); EXP2(s1, pb, 4); SB();
        F0 = FLOAD(21); o[3] = __builtin_amdgcn_mfma_f32_32x32x16_bf16(F1, __builtin_bit_cast(bf16x8, pw[2]), o[3], 0, 0, 0); EXP2(s1, pb, 6); SB();
        F1 = FLOAD(22); o[0] = __builtin_amdgcn_mfma_f32_32x32x16_bf16(F2, __builtin_bit_cast(bf16x8, pw[3]), o[0], 0, 0, 0); EXP2(s1, pb, 8); SB();
        F2 = FLOAD(23); o[1] = __builtin_amdgcn_mfma_f32_32x32x16_bf16(F0, __builtin_bit_cast(bf16x8, pw[3]), o[1], 0, 0, 0); EXP2(s1, pb, 10); SB();
        o[2] = __builtin_amdgcn_mfma_f32_32x32x16_bf16(F1, __builtin_bit_cast(bf16x8, pw[3]), o[2], 0, 0, 0); EXP2(s1, pb, 12); SB();
        o[3] = __builtin_amdgcn_mfma_f32_32x32x16_bf16(F2, __builtin_bit_cast(bf16x8, pw[3]), o[3], 0, 0, 0); EXP2(s1, pb, 14); SB();
#undef ADD4
#undef EXP2
#undef FADDR
#undef FLOAD
        asm volatile("s_waitcnt vmcnt(0) lgkmcnt(0)" ::: "memory");
        __builtin_amdgcn_s_barrier();
        const int tmp = bV; bV = bK; bK = bW; bW = tmp;
    }
    {
        float a0 = 0.f, a1 = 0.f;
#pragma unroll
        for (int r = 0; r < 16; ++r) { a0 += pa[r]; a1 += pb[r]; }
        l0 += a0; l1 += a1;
        pw[0] = (u32x4){cvtpk(pa[0], pa[1]), cvtpk(pa[2], pa[3]), cvtpk(pa[4], pa[5]), cvtpk(pa[6], pa[7])};
        pw[1] = (u32x4){cvtpk(pa[8], pa[9]), cvtpk(pa[10], pa[11]), cvtpk(pa[12], pa[13]), cvtpk(pa[14], pa[15])};
        pw[2] = (u32x4){cvtpk(pb[0], pb[1]), cvtpk(pb[2], pb[3]), cvtpk(pb[4], pb[5]), cvtpk(pb[6], pb[7])};
        pw[3] = (u32x4){cvtpk(pb[8], pb[9]), cvtpk(pb[10], pb[11]), cvtpk(pb[12], pb[13]), cvtpk(pb[14], pb[15])};
#pragma unroll
        for (int j = 0; j < 4; ++j)
#pragma unroll
            for (int b = 0; b < 4; ++b) o[b] = __builtin_amdgcn_mfma_f32_32x32x16_bf16(VFR(bV, j, b), __builtin_bit_cast(bf16x8, pw[j]), o[b], 0, 0, 0);
    }
    float l = l0 + l1;
#undef AT_DMA
#undef AT_ADV
#undef SB
#undef KFR
#undef VFR
    asm volatile("s_waitcnt vmcnt(0) lgkmcnt(0)" ::: "memory");
    __builtin_amdgcn_s_barrier();
    l += __shfl_xor(l, 32);
    const float inv = 1.0f / l;
    LAS float* xw = (LAS float*)(lds + AT_XOFF + wq * 16384);
    if (map == 1) {
        const float f = inv * lam;
#pragma unroll
        for (int b = 0; b < 4; ++b)
#pragma unroll
            for (int r = 0; r < 16; ++r) xw[(b * 16 + r) * 64 + lane] = o[b][r] * f;
    }
    __syncthreads();
    if (map == 0) {
        float ss = 0.f;
#pragma unroll
        for (int b = 0; b < 4; ++b)
#pragma unroll
            for (int r = 0; r < 16; ++r) { const float v = o[b][r] * inv - xw[(b * 16 + r) * 64 + lane]; o[b][r] = v; ss += v * v; }
        ss += __shfl_xor(ss, 32);
        const float rs = __builtin_amdgcn_rsqf(ss * (1.0f / VD) + EPS) * (1.0f - LAM_INIT);
        LAS unsigned char* stg = (LAS unsigned char*)xw;
#pragma unroll
        for (int b = 0; b < 4; ++b)
#pragma unroll
            for (int r4 = 0; r4 < 4; ++r4) {
                const int dv = 32 * b + 8 * r4 + 4 * hi;
                const f32x4 sg = *(const f32x4*)(sub_g + dv);
                u32x2 w; w.x = cvtpk(o[b][4 * r4 + 0] * rs * sg[0], o[b][4 * r4 + 1] * rs * sg[1]); w.y = cvtpk(o[b][4 * r4 + 2] * rs * sg[2], o[b][4 * r4 + 3] * rs * sg[3]);
                *(LAS u32x2*)(stg + r32 * 272 + dv * 2) = w;
            }
        asm volatile("s_waitcnt lgkmcnt(0)" ::: "memory");
        const bf16_t* GA = (const bf16_t*)(ws + WS_GA); bf16_t* MIX = (bf16_t*)(ws + WS_MIX);
        u32x4 gvs[8];
#pragma unroll
        for (int i = 0; i < 8; ++i) gvs[i] = *(const u32x4*)(GA + (size_t)(qrow0 + (lane >> 4) + 4 * i) * 1024 + h * 128 + (lane & 15) * 8);
#pragma unroll
        for (int i = 0; i < 8; ++i) {
            const int q = (lane >> 4) + 4 * i, ch = lane & 15;
            const u32x4 ov = *(const LAS u32x4*)(stg + q * 272 + ch * 16);
            const size_t tok = (size_t)(qrow0 + q);
            const u32x4 gv = gvs[i];
            u32x4 w;
            w.x = cvtpk(bf_lo(ov.x) * bf_lo(gv.x), bf_hi(ov.x) * bf_hi(gv.x)); w.y = cvtpk(bf_lo(ov.y) * bf_lo(gv.y), bf_hi(ov.y) * bf_hi(gv.y));
            w.z = cvtpk(bf_lo(ov.z) * bf_lo(gv.z), bf_hi(ov.z) * bf_hi(gv.z)); w.w = cvtpk(bf_lo(ov.w) * bf_lo(gv.w), bf_hi(ov.w) * bf_hi(gv.w));
            *(u32x4*)(MIX + tok * DM + h * 128 + ch * 8) = w;
        }
    }
    __syncthreads();
}

__device__ __forceinline__ void conv_unit(unsigned char* ws, LAS unsigned char* lds, int t0) {
    const int tid = threadIdx.x, lane = tid & 63, wid = tid >> 6, c0 = 2 * tid;
    const float* conv_w = KIN(I_CONVW); const float* conv_b = KIN(I_CONVB);
    const bf16_t* Y = (const bf16_t*)(ws + WS_Y);
    float y0[62], y1[62];
#pragma unroll
    for (int r = 0; r < 62; ++r) {
        const int row = t0 - 15 + r;
        unsigned yv = 0u;
        if (row >= 0 && row < SEQ) yv = *(const unsigned*)(Y + (size_t)row * CONVW + c0);
        y0[r] = bf_lo(yv); y1[r] = bf_hi(yv);
    }
    const f32x2 bias = *(const f32x2*)(conv_b + c0);
    float a0[32], a1[32];
#pragma unroll
    for (int t = 0; t < 32; ++t) { a0[t] = bias[0]; a1[t] = bias[1]; }
#pragma unroll
    for (int j = 0; j < CONVK; ++j) {
        const f32x2 w = *(const f32x2*)(conv_w + j * CONVW + c0);
#pragma unroll
        for (int t = 0; t < 32; ++t) { a0[t] += w[0] * y0[t + j]; a1[t] += w[1] * y1[t + j]; }
    }
    const bf16_t* GC = (const bf16_t*)(ws + WS_GC);
    unsigned gcv[32];
#pragma unroll
    for (int t = 0; t < 32; ++t) gcv[t] = *(const unsigned*)(GC + (size_t)(t0 + t) * CONVW + c0);
    float v[64];
#pragma unroll
    for (int t = 0; t < 32; ++t) { v[t] = a0[t] + a1[t]; v[32 + t] = a0[t] * a0[t] + a1[t] * a1[t]; }
#pragma unroll
    for (int h = 32; h >= 1; h >>= 1) {
        const bool up = (lane & h) != 0;
#pragma unroll
        for (int i = 0; i < h; ++i) {
            const float send = up ? v[i] : v[i + h], keep = up ? v[i + h] : v[i];
            v[i] = keep + __shfl_xor(send, h);
        }
    }
    LAS float* red = (LAS float*)lds;
    LAS float* stat = red + 512;
    red[wid * 64 + lane] = v[0];
    __syncthreads();
    if (tid < 32) {
        float s1 = 0.f, s2 = 0.f;
#pragma unroll
        for (int w = 0; w < 8; ++w) { s1 += red[w * 64 + tid]; s2 += red[w * 64 + 32 + tid]; }
        const float mean = s1 * (1.0f / CONVW), var = fmaxf(s2 * (1.0f / CONVW) - mean * mean, 0.f);
        stat[tid * 2] = mean; stat[tid * 2 + 1] = __builtin_amdgcn_rsqf(var + EPS);
    }
    __syncthreads();
    const float* ln_g = KIN(I_LNG); const float* ln_b = KIN(I_LNB);
    bf16_t* MIX = (bf16_t*)(ws + WS_MIX);
    const f32x2 lg = *(const f32x2*)(ln_g + c0), lb = *(const f32x2*)(ln_b + c0);
#pragma unroll
    for (int t = 0; t < 32; ++t) {
        const float mean = stat[t * 2], rstd = stat[t * 2 + 1];
        const float v0 = (a0[t] - mean) * rstd * lg[0] + lb[0], v1 = (a1[t] - mean) * rstd * lg[1] + lb[1];
        const unsigned gc = gcv[t];
        *(unsigned*)(MIX + (size_t)(t0 + t) * DM + ATTW + c0) = cvtpk(silu_f(v0) * bf_lo(gc), silu_f(v1) * bf_hi(gc));
    }
    __syncthreads();
}

#define XB_TMO      128
#define XB_XCNT(j)  (256  + 64 * (j))
#define XB_XSUB(j)  (1280 + 64 * (j))
#define XB_XGEN(j)  (2304 + 64 * (j))
#define XB_TOP      3328
#define XB_TOPGEN   3392
#define XCD_BAR_WORDS 3456
#define XB_SPIN_CAP (1u << 18)
__device__ __forceinline__ unsigned xb_ld(unsigned* p)              { return __hip_atomic_load(p, __ATOMIC_RELAXED, __HIP_MEMORY_SCOPE_AGENT); }
__device__ __forceinline__ unsigned xb_add(unsigned* p, unsigned v) { return __hip_atomic_fetch_add(p, v, __ATOMIC_RELAXED, __HIP_MEMORY_SCOPE_AGENT); }
__device__ __forceinline__ unsigned xb_xcc_id() { return (unsigned)__builtin_amdgcn_s_getreg((3 << 11) | 20) & 0xFu; }
#define XB_SPIN(cond, bar) do { unsigned _sp = 0; while (cond) { __builtin_amdgcn_s_sleep(1); \
    if ((++_sp & 255u) == 0u) { if (xb_ld(&(bar)[XB_TMO])) break; if (_sp > XB_SPIN_CAP) { atomicAdd(&(bar)[XB_TMO], 1u); break; } } } } while (0)
struct XcdBarrier { unsigned* bar; unsigned x; volatile LAS unsigned* st; };
__device__ __forceinline__ XcdBarrier xcd_barrier_post(unsigned* bar, volatile LAS unsigned* st) {
    XcdBarrier b; b.bar = bar; b.x = xb_xcc_id(); b.st = st;
    if (threadIdx.x == 0) st[3] = xb_add(&bar[XB_XCNT(b.x)], 1u);
    return b;
}
__device__ __forceinline__ void xcd_barrier_complete(unsigned* bar, unsigned x, unsigned& nloc, unsigned& nx, unsigned& uni) {
    const unsigned G = gridDim.x * gridDim.y * gridDim.z;
    unsigned sum, cnt, mine, sp = 0u, ok32;
    for (;;) {
        sum = 0u; cnt = 0u; mine = 0u; ok32 = 1u;
#pragma unroll
        for (unsigned j = 0; j < 16; ++j) { const unsigned c = xb_ld(&bar[XB_XCNT(j)]); sum += c; cnt += (c > 0u) ? 1u : 0u; mine = (j == x) ? c : mine; ok32 &= (c == ((j < 8u) ? 32u : 0u)) ? 1u : 0u; }
        if (sum == G) break;
        __builtin_amdgcn_s_sleep(1);
        if ((++sp & 255u) == 0u) { if (xb_ld(&bar[XB_TMO])) break; if (sp > XB_SPIN_CAP) { atomicAdd(&bar[XB_TMO], 1u); break; } }
    }
    nloc = mine > 0u ? mine : 1u; nx = cnt > 0u ? cnt : 1u; uni = (sum == G && G == 256u) ? ok32 : 0u;
}
__device__ __forceinline__ void xcd_barrier(const XcdBarrier& b) {
    asm volatile("s_waitcnt vmcnt(0)" ::: "memory");
    __syncthreads();
    if (threadIdx.x == 0) {
        unsigned* bar = b.bar;
        __builtin_amdgcn_s_waitcnt(0);
        unsigned nloc = b.st[0], nx = b.st[1];
        if (nloc == 0u) { unsigned uni; xcd_barrier_complete(bar, b.x, nloc, nx, uni); b.st[0] = nloc; b.st[1] = nx; b.st[2] = uni; }
        const unsigned old = xb_add(&bar[XB_XSUB(b.x)], 1u);
        const unsigned gen = old / nloc;
        if (old + 1u == (gen + 1u) * nloc) {
            __builtin_amdgcn_fence(__ATOMIC_RELEASE, "agent");
            asm volatile("s_waitcnt vmcnt(0)" ::: "memory");
            const unsigned og = xb_add(&bar[XB_TOP], 1u);
            const unsigned tg = og / nx;
            if (og + 1u == (tg + 1u) * nx) xb_add(&bar[XB_TOPGEN], 1u);
            else XB_SPIN(xb_ld(&bar[XB_TOPGEN]) == tg, bar);
            __builtin_amdgcn_fence(__ATOMIC_ACQUIRE, "agent");
            xb_add(&bar[XB_XGEN(b.x)], 1u);
            asm volatile("s_waitcnt vmcnt(0)" ::: "memory");
        } else {
            XB_SPIN(xb_ld(&bar[XB_XGEN(b.x)]) == gen, bar);
            __builtin_amdgcn_fence(__ATOMIC_ACQUIRE, "agent");
            asm volatile("s_waitcnt vmcnt(0)" ::: "memory");
        }
    }
    __syncthreads();
}

__global__ void __launch_bounds__(512, 2) fwd_kernel(Args args) {
    extern __shared__ __attribute__((aligned(16))) unsigned char lds_raw[];
    LAS unsigned char* lds = (LAS unsigned char*)lds_raw;
    cg::grid_group grid = cg::this_grid();
    const int tid = threadIdx.x, lane = tid & 63, wave = __builtin_amdgcn_readfirstlane(tid >> 6);
    const int G = gridDim.x, bx = blockIdx.x;
    const int gw = bx * 8 + wave, NGW = G * 8;
    const int lo = args.ph_lo, hi = args.ph_hi;
#define IN(k) (lo <= (k) && (k) < hi)
#define BOTH(k) (IN(k) && IN((k) + 1))
    volatile LAS unsigned* bst = (volatile LAS unsigned*)(lds + LDS_BYTES - 64);
    if (tid < 16) bst[tid] = 0u;
    __syncthreads();
    const XcdBarrier gbar = xcd_barrier_post((unsigned*)(KWS + WS_BAR), bst);
    if (lo > 1000) grid.sync();
#define GRID_SYNC() xcd_barrier(gbar)

    if (IN(0)) { phase0(lds, bx, G, lane, wave); __syncthreads(); }
    if (IN(1)) { phase1(lds, gw, NGW, lane, wave); if (BOTH(1)) GRID_SYNC(); }
    int vb = bx;
    if (BOTH(1) && bst[2] != 0u) vb = __builtin_amdgcn_readfirstlane((int)(bst[3] * 8u + gbar.x));
    const bool split2 = (G == 256) && (hi - lo == 5);
    if (IN(2)) {
        EpiIn E;
        if (split2) {
            { SchedIn S{(const char*)KWS, vb, G, 0, 768}; pg8::gemm_phase<EpiIn, SchedIn>(lds, S, E); }
            GRID_SYNC();
            if (vb < 136) { SchedIn S{(const char*)KWS, vb, G, 768, 904}; pg8::gemm_phase<EpiIn, SchedIn>(lds, S, E); }
            else {
                const int j = vb - 136;
                unsigned char* ws = KWS;
                for (int cu = j; cu < SEQ / 32; cu += 120) conv_unit(ws, lds, 32 * cu);
                if (j >= 16) {
                    LAS float* scr = (LAS float*)(lds + wave * 16640);
                    const float* w_out = KIN(I_WOUT); bf16_t* WO = (bf16_t*)(ws + WS_WO);
                    for (int it = (j - 16) * 8 + wave; it < 32 * (DM / 64); it += 104 * 8) { const int kb = it / (DM / 64), nb = it % (DM / 64); transpose_item(w_out, DM, WO, kb * 64, nb * 64, false, scr, lane); }
                }
            }
        } else {
            SchedIn S{(const char*)KWS, vb, G, 0, 904};
            pg8::gemm_phase<EpiIn, SchedIn>(lds, S, E);
            if (G == 256 && vb >= 136) {
                LAS float* scr = (LAS float*)(lds + wave * 16640);
                const float* w_out = KIN(I_WOUT); bf16_t* WO = (bf16_t*)(KWS + WS_WO);
                for (int it = (vb - 136) * 8 + wave; it < 32 * (DM / 64); it += 120 * 8) { const int kb = it / (DM / 64), nb = it % (DM / 64); transpose_item(w_out, DM, WO, kb * 64, nb * 64, false, scr, lane); }
            }
        }
        if (BOTH(2)) GRID_SYNC();
    }
    if (IN(3)) {
        const float* lq1 = KIN(I_LQ1); const float* lk1 = KIN(I_LK1); const float* lq2 = KIN(I_LQ2); const float* lk2 = KIN(I_LK2);
        const float d1 = wave_sum(lq1[lane] * lk1[lane]), d2 = wave_sum(lq2[lane] * lk2[lane]);
        const float lam = __expf(d1) - __expf(d2) + LAM_INIT;
        const float* qg = KIN(I_QG); const float* kg = KIN(I_KG);
        const float mq = wave_max(fabsf(qg[lane])), mk = wave_max(fabsf(kg[lane]));
        const float negM = -(QSCALE * 64.0f * mq * mk * 1.01f);
        unsigned char* ws = KWS;
        if (!split2) for (int t0 = vb * 32; t0 < SEQ; t0 += G * 32) conv_unit(ws, lds, t0);
        const float* sub_g = KIN(I_SUBG);
        for (int u = vb; u < NH * (SEQ / 128); u += G) attn_unit(ws, sub_g, lds, u & 7, u >> 3, negM, lam);
        if (BOTH(3)) GRID_SYNC();
    }
    if (IN(4)) {
        SchedOut S{(const char*)KWS, vb, G};
        EpiOut E;
        pg8::gemm_phase<EpiOut, SchedOut>(lds, S, E);
    }
#undef IN
#undef BOTH
}

extern "C" void kernel_launch(void* const* d_in, const int* in_sizes, int n_in, void* d_out, int out_size, void* d_ws, size_t ws_size, hipStream_t stream) {
    static int grid = 0;
    if (grid == 0) {
        if (n_in != 20 || out_size != SEQ * DM || ws_size < WS_END) { fprintf(stderr, "kernel_launch: unexpected shapes (n_in %d out %d ws %zu)\n", n_in, out_size, ws_size); grid = -1; return; }
        int dev = 0, cus = 0, per_cu = 0;
        if (hipGetDevice(&dev) != hipSuccess || hipDeviceGetAttribute(&cus, hipDeviceAttributeMultiprocessorCount, dev) != hipSuccess) { grid = -1; return; }
        if (hipFuncSetAttribute((const void*)fwd_kernel, hipFuncAttributeMaxDynamicSharedMemorySize, LDS_BYTES) != hipSuccess) { fprintf(stderr, "kernel_launch: hipFuncSetAttribute failed\n"); grid = -1; return; }
        if (hipOccupancyMaxActiveBlocksPerMultiprocessor(&per_cu, (const void*)fwd_kernel, 512, LDS_BYTES) != hipSuccess || per_cu < 1) { fprintf(stderr, "kernel_launch: occupancy query gave %d\n", per_cu); per_cu = 1; }
        (void)hipGetLastError();
        grid = cus * 1;
    }
    if (grid < 0) return;
    (void)hipMemsetAsync((char*)d_ws + WS_MOD, 0, WS_ZERO_BYTES, stream);
    Args a{};
    for (int i = 0; i < 20; ++i) a.in[i] = (const float*)d_in[i];
    a.out = (float*)d_out; a.ws = (unsigned char*)d_ws;
#if MK_N_LAUNCHES == 1
    a.ph_lo = 0; a.ph_hi = 5;
    void* kargs[] = {&a};
    hipError_t e = hipLaunchCooperativeKernel((const void*)fwd_kernel, dim3(grid), dim3(512), kargs, LDS_BYTES, stream);
    if (e != hipSuccess) {
        fprintf(stderr, "cooperative launch failed: %s (grid %d); falling back to one launch per phase\n", hipGetErrorString(e), grid);
        (void)hipGetLastError();
        for (int ph = 0; ph < 5; ++ph) { a.ph_lo = ph; a.ph_hi = ph + 1; hipLaunchKernelGGL(fwd_kernel, dim3(grid), dim3(512), LDS_BYTES, stream, a); }
    }
#else
    for (int ph = 0; ph < 5; ++ph) {
        a.ph_lo = ph; a.ph_hi = ph + 1;
        hipLaunchKernelGGL(fwd_kernel, dim3(grid), dim3(512), LDS_BYTES, stream, a);
    }
#endif
}
```

```cpp
#include <hip/hip_runtime.h>
#include <hip/hip_cooperative_groups.h>
#include <cstdio>
#include <cstdint>
namespace cg = cooperative_groups;

#ifndef MK_N_LAUNCHES
#define MK_N_LAUNCHES 1
#endif

#define LAS __attribute__((address_space(3)))
typedef unsigned short bf16_t;
typedef short bf16x8 __attribute__((ext_vector_type(8)));
typedef float f32x2 __attribute__((ext_vector_type(2)));
typedef float f32x4 __attribute__((ext_vector_type(4)));
typedef float f32x16 __attribute__((ext_vector_type(16)));
typedef unsigned u32x2 __attribute__((ext_vector_type(2)));
typedef unsigned u32x4 __attribute__((ext_vector_type(4)));
typedef __bf16 bf16x2_t __attribute__((ext_vector_type(2)));

constexpr int DM = 2048, SEQ = 8192, CTXL = 256, NTOK = SEQ + CTXL, INW = 7168;
constexpr int NH = 8, HD = 64, VD = 128, ATTW = 1024, CONVW = 1024, CONVK = 31;
constexpr float EPS = 1e-6f;
constexpr float LOG2E = 1.4426950408889634f;
constexpr float QSCALE = 0.125f * LOG2E;
constexpr float LAM_INIT = 0.2f;

constexpr size_t MiB = 1u << 20;
constexpr size_t WS_MOD = 0;
constexpr size_t WS_BAR = 49152;
constexpr size_t WS_P0CNT = 63488;
constexpr size_t WS_ZERO_BYTES = 65536;
constexpr size_t WS_TAB = 65536;
constexpr size_t WS_WT = 1 * MiB;
constexpr size_t WS_WO = 29 * MiB;
constexpr size_t WS_H = 40 * MiB;
constexpr size_t WS_Q = 74 * MiB;
constexpr size_t WS_K = 90 * MiB;
constexpr size_t WS_VT = 107 * MiB;
constexpr size_t WS_GA = 124 * MiB;
constexpr size_t WS_Y = 140 * MiB;
constexpr size_t WS_GC = 156 * MiB;
constexpr size_t WS_MIX = 172 * MiB;
constexpr size_t WS_END = 204 * MiB;

constexpr int LDS_BYTES = 147456;

__device__ __forceinline__ unsigned cvtpk(float lo, float hi) { f32x2 v = {lo, hi}; bf16x2_t b = __builtin_convertvector(v, bf16x2_t); return __builtin_bit_cast(unsigned, b); }
__device__ __forceinline__ float bf_lo(unsigned u) { return __builtin_bit_cast(float, u << 16); }
__device__ __forceinline__ float bf_hi(unsigned u) { return __builtin_bit_cast(float, u & 0xffff0000u); }
__device__ __forceinline__ float wave_sum(float v) {
#pragma unroll
    for (int o = 1; o < 64; o <<= 1) v += __shfl_xor(v, o);
    return v;
}
__device__ __forceinline__ float wave_max(float v) {
#pragma unroll
    for (int o = 1; o < 64; o <<= 1) v = fmaxf(v, __shfl_xor(v, o));
    return v;
}
__device__ __forceinline__ float silu_f(float v) { return v * __builtin_amdgcn_rcpf(1.0f + __builtin_amdgcn_exp2f(-v * LOG2E)); }
__device__ __forceinline__ float sigmoid_f(float v) { return __builtin_amdgcn_rcpf(1.0f + __builtin_amdgcn_exp2f(-v * LOG2E)); }
__device__ __forceinline__ float fadd_s(float a, float b) { float r; asm("v_add_f32_e32 %0, %1, %2" : "=v"(r) : "v"(a), "v"(b)); return r; }
__device__ __forceinline__ int perm5(int f5) { return 16 * ((f5 >> 2) & 1) + 4 * (f5 >> 3) + (f5 & 3); }

namespace pg8 {
constexpr int BM = 256, BK = 64, HALF = 128, HTB = HALF * BK * 2, STAGE_BYTES = 8 * HTB;
constexpr int GK = 2048;
__device__ __forceinline__ int lds_byte(int r, int c) { const int st = (r >> 4) * 2 + (c >> 5), rr = r & 15, cc = c & 31, ob = rr * 64 + cc * 2; return st * 1024 + (ob ^ (((ob >> 9) & 1) << 5)); }
__device__ __forceinline__ void stage_rc(int b, int& R, int& C) { const int st = b / 1024, sb = b % 1024, swz = sb ^ (((sb >> 9) & 1) << 5); R = (st >> 1) * 16 + swz / 64; C = (st & 1) * 32 + (swz % 64) / 2; }

struct Unit { const char* a; const char* b; int kind, pm, pn; };

template <class Epi, class Sched>
__device__ __forceinline__ void gemm_phase(LAS unsigned char* lds, const Sched& S, const Epi& E) {
    const int tid = threadIdx.x, wid = __builtin_amdgcn_readfirstlane(tid >> 6), lane = tid & 63, wr = wid >> 2, wc = wid & 3, fr = lane & 15, fq = lane >> 4;
    constexpr int K = GK, nt = K / BK;
    unsigned voffA[2];
#pragma unroll
    for (int i = 0; i < 2; ++i) { int R, C; stage_rc(tid * 16 + i * 8192, R, C); voffA[i] = (unsigned)(R * K + C) * 2u; }
    const size_t kstep = (size_t)(BK * 2);
    const size_t hstep = (size_t)HALF * K * 2;
    const unsigned ldsw = (unsigned)wid * 1024u;
    const int aoff = lds_byte(wr * 64 + fr, fq * 8), boff = lds_byte(wc * 32 + fr, fq * 8);
#define PG8_SA(b, h) (((b) * 2 + (h)) * HTB)
#define PG8_SB(b, h) ((4 + (b) * 2 + (h)) * HTB)
#define PG8_STAGE(bufoff, gbase) do { _Pragma("unroll") for (int _i = 0; _i < 2; ++_i) \
        __builtin_amdgcn_global_load_lds((const unsigned*)((const char*)(gbase) + voffA[_i]), (LAS unsigned*)(lds + (bufoff) + ldsw + _i * 8192), 16, 0, 0); } while (0)
#define PG8_LDA(dst, b, h) do { _Pragma("unroll") for (int m = 0; m < 4; ++m) _Pragma("unroll") for (int k = 0; k < 2; ++k) dst[m][k] = *(const LAS bf16x8*)(lds + PG8_SA(b, h) + aoff + m * 2048 + k * 1024); } while (0)
#define PG8_LDB(dst, b, h) do { _Pragma("unroll") for (int n = 0; n < 2; ++n) _Pragma("unroll") for (int k = 0; k < 2; ++k) dst[n][k] = *(const LAS bf16x8*)(lds + PG8_SB(b, h) + boff + n * 2048 + k * 1024); } while (0)
#define PG8_MMA(ai, bj, At, Bt) do { __builtin_amdgcn_s_setprio(1); _Pragma("unroll") for (int m = 0; m < 4; ++m) _Pragma("unroll") for (int n = 0; n < 2; ++n) _Pragma("unroll") for (int k = 0; k < 2; ++k) \
        acc[ai][bj][m][n] = __builtin_amdgcn_mfma_f32_16x16x32_bf16(Bt[n][k], At[m][k], acc[ai][bj][m][n], 0, 0, 0); __builtin_amdgcn_s_setprio(0); } while (0)
#define PG8_WAIT_V(n) asm volatile("s_waitcnt vmcnt(" #n ")" ::: "memory")
#define PG8_WAIT_L(n) asm volatile("s_waitcnt lgkmcnt(" #n ")" ::: "memory")
#define PG8_BAR __builtin_amdgcn_s_barrier()
#define PG8_SCHED __builtin_amdgcn_sched_barrier(0)
    Unit cur, nxt; int ui = 0;
    if (!S.next(0, cur)) return;
    f32x4 acc[2][2][4][2];
#pragma unroll
    for (int a = 0; a < 2; ++a)
#pragma unroll
        for (int b = 0; b < 2; ++b)
#pragma unroll
            for (int m = 0; m < 4; ++m)
#pragma unroll
                for (int n = 0; n < 2; ++n) acc[a][b][m][n] = (f32x4){0.f, 0.f, 0.f, 0.f};
    bf16x8 At[4][2], B0[2][2], B1[2][2];
    const char* cA = cur.a; const char* cB = cur.b;
    PG8_STAGE(PG8_SB(0, 0), cB); PG8_STAGE(PG8_SB(0, 1), cB + hstep); PG8_STAGE(PG8_SA(0, 0), cA); PG8_STAGE(PG8_SA(0, 1), cA + hstep);
    if (wr == 1) PG8_BAR;
    PG8_WAIT_V(2); PG8_BAR;
    PG8_STAGE(PG8_SB(1, 0), cB + kstep); PG8_STAGE(PG8_SA(1, 0), cA + kstep); PG8_STAGE(PG8_SB(1, 1), cB + hstep + kstep);
    PG8_WAIT_V(6); PG8_BAR;
    for (;;) {
        const bool has_next = S.next(ui + 1, nxt);
        const char* nA = has_next ? nxt.a : cA; const char* nB = has_next ? nxt.b : cB;
        for (int t = 0; t < nt; t += 2) {
            const bool last = (t == nt - 2);
            const char* a1 = cA + (size_t)(t + 1) * kstep;
            const char* a2 = last ? nA : cA + (size_t)(t + 2) * kstep; const char* b2 = last ? nB : cB + (size_t)(t + 2) * kstep;
            const char* a3 = a2 + kstep; const char* b3 = b2 + kstep;
            PG8_LDB(B0, 0, 0); PG8_LDB(B1, 0, 1); PG8_SCHED; PG8_LDA(At, 0, 0); PG8_STAGE(PG8_SA(1, 1), a1 + hstep);
            PG8_WAIT_V(8); PG8_WAIT_L(0); PG8_BAR; PG8_MMA(0, 0, At, B0); PG8_MMA(0, 1, At, B1); PG8_BAR; PG8_SCHED;
            PG8_LDA(At, 0, 1); PG8_STAGE(PG8_SB(0, 0), b2); PG8_STAGE(PG8_SB(0, 1), b2 + hstep); PG8_STAGE(PG8_SA(0, 0), a2);
            PG8_WAIT_V(8); PG8_WAIT_L(0); PG8_BAR; PG8_MMA(1, 0, At, B0); PG8_MMA(1, 1, At, B1); PG8_BAR; PG8_SCHED;
            PG8_LDB(B0, 1, 0); PG8_LDB(B1, 1, 1); PG8_SCHED; PG8_LDA(At, 1, 0); PG8_STAGE(PG8_SA(0, 1), a2 + hstep);
            PG8_WAIT_V(8); PG8_WAIT_L(0); PG8_BAR; PG8_MMA(0, 0, At, B0); PG8_MMA(0, 1, At, B1); PG8_BAR; PG8_SCHED;
            PG8_LDA(At, 1, 1); PG8_STAGE(PG8_SB(1, 0), b3); PG8_STAGE(PG8_SB(1, 1), b3 + hstep); PG8_STAGE(PG8_SA(1, 0), a3);
            PG8_WAIT_V(8); PG8_WAIT_L(0); PG8_BAR; PG8_MMA(1, 0, At, B0); PG8_MMA(1, 1, At, B1); PG8_BAR; PG8_SCHED;
        }
        if (wr == 0) PG8_BAR;
        E(acc, cur, wr, wc, fr, fq);
        if (!has_next) break;
#pragma unroll
        for (int a = 0; a < 2; ++a)
#pragma unroll
            for (int b = 0; b < 2; ++b)
#pragma unroll
                for (int m = 0; m < 4; ++m)
#pragma unroll
                    for (int n = 0; n < 2; ++n) acc[a][b][m][n] = (f32x4){0.f, 0.f, 0.f, 0.f};
        cur = nxt; cA = nA; cB = nB; ++ui;
        if (wr == 1) PG8_BAR;
    }
    PG8_WAIT_V(0);
    PG8_BAR;
#undef PG8_SA
#undef PG8_SB
#undef PG8_STAGE
#undef PG8_LDA
#undef PG8_LDB
#undef PG8_MMA
#undef PG8_WAIT_V
#undef PG8_WAIT_L
#undef PG8_BAR
#undef PG8_SCHED
}
}

struct Args { const float* in[20]; float* out; unsigned char* ws; int ph_lo, ph_hi; };
template <int OFF> __device__ __forceinline__ unsigned long long karg64() {
    unsigned long long v;
    asm volatile("s_load_dwordx2 %0, %1, %2\n\ts_waitcnt lgkmcnt(0)" : "=s"(v) : "s"(__builtin_amdgcn_kernarg_segment_ptr()), "n"(OFF) : "memory");
    return v;
}
#define GAS __attribute__((address_space(1)))
#define KIN(i) ((const float*)(GAS const float*)karg64<8 * (i)>())
#define KOUT ((float*)(GAS float*)karg64<160>())
#define KWS ((unsigned char*)(GAS unsigned char*)karg64<168>())
enum { I_X = 0, I_C, I_CTX, I_CCTX, I_WADA, I_BADA, I_NORMG, I_WIN, I_QG, I_KG, I_LQ1, I_LK1, I_LQ2, I_LK2, I_SUBG, I_CONVW, I_CONVB, I_LNG, I_LNB, I_WOUT };

struct SchedIn {
    const char* ws; int c, G, L0, L1;
    __device__ __forceinline__ bool next(int i, pg8::Unit& u) const {
        const int L = L0 + i * G + c; if (L >= L1) return false;
        constexpr size_t RB = (size_t)DM * 2;
        const char* H = ws + WS_H; const char* WT = ws + WS_WT;
        if (L < 768) {
            int wgid = (L % 8) * 96 + L / 8;
            const int gid = wgid / 192, rem = wgid % 192;
            const int pm = gid * 8 + (rem % 8), pn = rem / 8;
            u.a = H + (size_t)(256 + 256 * pm) * RB; u.b = WT + (size_t)(256 * pn) * RB; u.pm = pm; u.pn = pn;
            u.kind = (pn < 8) ? 0 : ((pn >= 12 && pn < 20) ? 2 : 1);
        } else if (L < 900) {
            const int idx = L - 768, pm = idx & 3, pn = idx >> 2;
            u.a = WT + (size_t)(6144 + 256 * pm) * RB; u.b = H + (size_t)(256 * pn) * RB; u.pm = pm; u.pn = pn; u.kind = 3;
        } else {
            const int pn = L - 900;
            u.a = H; u.b = WT + (size_t)(1024 + 256 * pn) * RB; u.pm = 0; u.pn = pn; u.kind = 4;
        }
        return true;
    }
};
struct SchedOut {
    const char* ws; int c, G;
    __device__ __forceinline__ bool next(int i, pg8::Unit& u) const {
        const int L = i * G + c; if (L >= 256) return false;
        constexpr size_t RB = (size_t)DM * 2;
        int wgid = (L % 8) * 32 + L / 8;
        const int gid = wgid / 64, rem = wgid % 64;
        const int pm = gid * 8 + (rem % 8), pn = rem / 8;
        u.a = ws + WS_MIX + (size_t)(256 * pm) * RB; u.b = ws + WS_WO + (size_t)(256 * pn) * RB; u.pm = pm; u.pn = pn; u.kind = 5;
        return true;
    }
};

struct EpiIn {
    __device__ __forceinline__ void operator()(const f32x4 (&acc)[2][2][4][2], const pg8::Unit& u, int wr, int wc, int fr, int fq) const {
        const int kind = u.kind;
        unsigned char* ws = KWS;
        if (kind == 0 || kind == 4) {
            const bool isq = (kind == 0) && (u.pn < 4);
            const float* gsrc = isq ? KIN(I_QG) : KIN(I_KG);
            const float osc = isq ? QSCALE : 1.0f;
            const f32x2* tab = (const f32x2*)(ws + WS_TAB);
            f32x4 g[2][2];
#pragma unroll
            for (int bj = 0; bj < 2; ++bj)
#pragma unroll
                for (int n = 0; n < 2; ++n) g[bj][n] = *(const f32x4*)(gsrc + 32 * bj + 16 * n + 4 * fq);
            bf16_t* dst = (bf16_t*)(ws + (isq ? WS_Q : WS_K));
            const int rowoff = (kind == 0 && !isq) ? CTXL : 0;
            const int G = 4 * (u.pn & 3) + wc;
#pragma unroll
            for (int ai = 0; ai < 2; ++ai) {
                const int rpos = 4 * u.pm + 2 * ai + wr;
                f32x4 cr0, cr1;
                if (kind == 0) { const f32x4* tp = (const f32x4*)(tab + rpos * 16 + 4 * fq); cr0 = tp[0]; cr1 = tp[1]; }
                else { cr0 = (f32x4){1.f, 0.f, 1.f, 0.f}; cr1 = cr0; }
#pragma unroll
                for (int m = 0; m < 4; ++m) {
                    const int t = 256 * u.pm + 128 * ai + 64 * wr + 16 * m + fr;
                    float ss = 0.f;
#pragma unroll
                    for (int bj = 0; bj < 2; ++bj)
#pragma unroll
                        for (int n = 0; n < 2; ++n) { const f32x4 v = acc[ai][bj][m][n]; ss += (v[0] * v[0] + v[1] * v[1]) + (v[2] * v[2] + v[3] * v[3]); }
                    ss += __shfl_xor(ss, 16); ss += __shfl_xor(ss, 32);
                    const float rstd = __builtin_amdgcn_rsqf(ss * (1.0f / 64.0f) + EPS) * osc;
                    f32x4 cc0, cc1;
                    if (kind == 0) { const f32x4* tp = (const f32x4*)(tab + (16 * m + fr) * 16 + 4 * fq); cc0 = tp[0]; cc1 = tp[1]; }
                    else { cc0 = (f32x4){1.f, 0.f, 1.f, 0.f}; cc1 = cc0; }
                    bf16_t* rowp = dst + (size_t)(rowoff + t) * 1024 + G * 64 + 8 * fq;
#pragma unroll
                    for (int bj = 0; bj < 2; ++bj) {
                        const f32x4 x1 = acc[ai][bj][m][0] * g[bj][0] * rstd, x2 = acc[ai][bj][m][1] * g[bj][1] * rstd;
                        const f32x4 ca = bj == 0 ? cr0 : cc0, cb = bj == 0 ? cr1 : cc1;
                        const float co[4] = {ca[0], ca[2], cb[0], cb[2]}, si[4] = {ca[1], ca[3], cb[1], cb[3]};
                        float o1[4], o2[4];
#pragma unroll
                        for (int e = 0; e < 4; ++e) { o1[e] = x1[e] * co[e] - x2[e] * si[e]; o2[e] = x2[e] * co[e] + x1[e] * si[e]; }
                        u32x4 w; w.x = cvtpk(o1[0], o1[1]); w.y = cvtpk(o1[2], o1[3]); w.z = cvtpk(o2[0], o2[1]); w.w = cvtpk(o2[2], o2[3]);
                        *(u32x4*)(rowp + 32 * bj) = w;
                    }
                }
            }
        } else if (kind == 1) {
            const bool isa = u.pn < 12; const int pnl = isa ? (u.pn - 8) : (u.pn - 20);
            bf16_t* dst = (bf16_t*)(ws + (isa ? WS_GA : WS_GC));
#pragma unroll
            for (int ai = 0; ai < 2; ++ai)
#pragma unroll
                for (int m = 0; m < 4; ++m) {
                    const int t = 256 * u.pm + 128 * ai + 64 * wr + 16 * m + fr;
                    bf16_t* rowp = dst + (size_t)t * 1024 + 256 * pnl + 32 * wc + 8 * fq;
#pragma unroll
                    for (int bj = 0; bj < 2; ++bj) {
                        const f32x4 v0 = acc[ai][bj][m][0], v1 = acc[ai][bj][m][1];
                        u32x4 w; w.x = cvtpk(silu_f(v0[0]), silu_f(v0[1])); w.y = cvtpk(silu_f(v0[2]), silu_f(v0[3]));
                        w.z = cvtpk(silu_f(v1[0]), silu_f(v1[1])); w.w = cvtpk(silu_f(v1[2]), silu_f(v1[3]));
                        *(u32x4*)(rowp + 128 * bj) = w;
                    }
                }
        } else if (kind == 2) {
            const int pnl = u.pn - 12;
            bf16_t* Y = (bf16_t*)(ws + WS_Y);
#pragma unroll
            for (int ai = 0; ai < 2; ++ai)
#pragma unroll
                for (int m = 0; m < 4; ++m) {
                    const int t = 256 * u.pm + 128 * ai + 64 * wr + 16 * m + fr;
                    bf16_t* rowp = Y + (size_t)t * 1024 + 128 * pnl + 32 * wc + 8 * fq;
                    const f32x4 a0 = acc[ai][0][m][0], a1 = acc[ai][0][m][1], g0 = acc[ai][1][m][0], g1 = acc[ai][1][m][1];
                    u32x4 w; w.x = cvtpk(a0[0] * sigmoid_f(g0[0]), a0[1] * sigmoid_f(g0[1])); w.y = cvtpk(a0[2] * sigmoid_f(g0[2]), a0[3] * sigmoid_f(g0[3]));
                    w.z = cvtpk(a1[0] * sigmoid_f(g1[0]), a1[1] * sigmoid_f(g1[1])); w.w = cvtpk(a1[2] * sigmoid_f(g1[2]), a1[3] * sigmoid_f(g1[3]));
                    *(u32x4*)rowp = w;
                }
        } else {
            const int sfq = (fq == 1) ? 2 : ((fq == 2) ? 1 : fq);
            bf16_t* VT = (bf16_t*)(ws + WS_VT);
#pragma unroll
            for (int ai = 0; ai < 2; ++ai)
#pragma unroll
                for (int m = 0; m < 4; ++m) {
                    const int f = 256 * u.pm + 128 * ai + 64 * wr + 16 * m + fr;
                    bf16_t* rowp = VT + (size_t)f * NTOK + 256 * u.pn + 32 * wc + 4 * sfq;
#pragma unroll
                    for (int bj = 0; bj < 2; ++bj)
#pragma unroll
                        for (int n = 0; n < 2; ++n) { const f32x4 v = acc[ai][bj][m][n]; u32x2 w; w.x = cvtpk(v[0], v[1]); w.y = cvtpk(v[2], v[3]); *(u32x2*)(rowp + 128 * bj + 16 * n) = w; }
                }
        }
    }
};
struct EpiOut {
    __device__ __forceinline__ void operator()(const f32x4 (&acc)[2][2][4][2], const pg8::Unit& u, int wr, int wc, int fr, int fq) const {
        const float* gate = (const float*)(KWS + WS_MOD) + 4096; const float* gb = KIN(I_BADA) + 4096;
        const float* x = KIN(I_X); float* out = KOUT;
        const int col0 = 256 * u.pn + 32 * wc + 4 * fq;
        f32x4 gv[2][2];
#pragma unroll
        for (int bj = 0; bj < 2; ++bj)
#pragma unroll
            for (int n = 0; n < 2; ++n) gv[bj][n] = *(const f32x4*)(gate + col0 + 128 * bj + 16 * n) + *(const f32x4*)(gb + col0 + 128 * bj + 16 * n);
#pragma unroll
        for (int ai = 0; ai < 2; ++ai)
#pragma unroll
            for (int mh = 0; mh < 2; ++mh) {
                f32x4 xv[2][2][2];
#pragma unroll
                for (int mm = 0; mm < 2; ++mm) {
                    const size_t off = (size_t)(256 * u.pm + 128 * ai + 64 * wr + 16 * (2 * mh + mm) + fr) * DM + col0;
#pragma unroll
                    for (int bj = 0; bj < 2; ++bj)
#pragma unroll
                        for (int n = 0; n < 2; ++n) xv[mm][bj][n] = __builtin_nontemporal_load((const f32x4*)(x + off + 128 * bj + 16 * n));
                }
#pragma unroll
                for (int mm = 0; mm < 2; ++mm) {
                    const size_t off = (size_t)(256 * u.pm + 128 * ai + 64 * wr + 16 * (2 * mh + mm) + fr) * DM + col0;
#pragma unroll
                    for (int bj = 0; bj < 2; ++bj)
#pragma unroll
                        for (int n = 0; n < 2; ++n) *(f32x4*)(out + off + 128 * bj + 16 * n) = xv[mm][bj][n] + gv[bj][n] * acc[ai][bj][2 * mh + mm][n];
                }
            }
    }
};

__device__ __forceinline__ int win_dest_row(int s) {
    if (s < 2048) { const int base = s & ~1023, ss = s & 1023, G = ss >> 6, d = ss & 63; return base + 256 * (G >> 2) + 128 * (d >> 5) + 32 * (G & 3) + (d & 31); }
    if (s < 3072) return 6144 + (s - 2048);
    if (s < 4096) { const int f = s - 3072; return 2048 + (f & ~31) + perm5(f & 31); }
    if (s < 6144) { const int isg = s >= 5120 ? 1 : 0, ch = s - 4096 - 1024 * isg; return 3072 + 256 * (ch >> 7) + 128 * isg + (ch & 96) + perm5(ch & 31); }
    const int f = s - 6144; return 5120 + (f & ~31) + perm5(f & 31);
}
__device__ __forceinline__ void transpose_item(const float* W, int N, bf16_t* WT, int k0, int n0, bool is_in, LAS float* scr, int lane) {
    const int lr = lane >> 4, lc = (lane & 15) * 4;
    f32x4 v[16];
#pragma unroll
    for (int i = 0; i < 16; ++i) v[i] = __builtin_nontemporal_load((const f32x4*)(W + (size_t)(k0 + 4 * i + lr) * N + n0 + lc));
#pragma unroll
    for (int i = 0; i < 16; ++i) { LAS float* d = scr + (4 * i + lr) * 65 + lc; d[0] = v[i][0]; d[1] = v[i][1]; d[2] = v[i][2]; d[3] = v[i][3]; }
    asm volatile("s_waitcnt lgkmcnt(0)" ::: "memory");
    const int c = lane & 7;
#pragma unroll
    for (int j = 0; j < 8; ++j) {
        const int n = (lane >> 3) + 8 * j; const LAS float* s = scr + (8 * c) * 65 + n;
        u32x4 o; o.x = cvtpk(s[0 * 65], s[1 * 65]); o.y = cvtpk(s[2 * 65], s[3 * 65]); o.z = cvtpk(s[4 * 65], s[5 * 65]); o.w = cvtpk(s[6 * 65], s[7 * 65]);
        const int dr = is_in ? win_dest_row(n0 + n) : (n0 + n);
        *(u32x4*)(WT + (size_t)dr * DM + k0 + 8 * c) = o;
    }
    asm volatile("s_waitcnt lgkmcnt(0)" ::: "memory");
}

__device__ __forceinline__ void phase0(LAS unsigned char* lds, int bx, int G, int lane, int wave) {
    unsigned char* ws = KWS;
    const float* w_ada = KIN(I_WADA); const float* cv = KIN(I_C); const float* ccv = KIN(I_CCTX);
    float* modx = (float*)(ws + WS_MOD);
    LAS float* red = (LAS float*)lds;
    for (int wi = bx; wi < 256; wi += G) {
        const int cc = wi & 31, kb = ((wi >> 5) * 8 + wave) * 32, cb = cc * 192 + lane * 4;
        f32x4 ax = {0.f, 0.f, 0.f, 0.f}, ac = {0.f, 0.f, 0.f, 0.f};
        if (lane < 48) {
#pragma unroll
            for (int k = 0; k < 32; ++k) {
                const f32x4 w = __builtin_nontemporal_load((const f32x4*)(w_ada + (size_t)(kb + k) * 6144 + cb));
                const float sx = silu_f(cv[kb + k]), sc = silu_f(ccv[kb + k]);
                ax += w * sx; ac += w * sc;
            }
            *(LAS f32x4*)(red + (wave * 2 + 0) * 192 + lane * 4) = ax;
            *(LAS f32x4*)(red + (wave * 2 + 1) * 192 + lane * 4) = ac;
        }
        __syncthreads();
        {
            const int t = threadIdx.x;
            if (t < 384) {
                const int vec = t / 192, col = t - vec * 192;
                float s = 0.f;
#pragma unroll
                for (int w = 0; w < 8; ++w) s += red[(w * 2 + vec) * 192 + col];
                unsafeAtomicAdd(modx + vec * 6144 + cc * 192 + col, s);
            }
        }
        __syncthreads();
    }
    asm volatile("s_waitcnt vmcnt(0)" ::: "memory");
    __syncthreads();
    if (threadIdx.x == 0) __hip_atomic_fetch_add((unsigned*)(ws + WS_P0CNT), 1u, __ATOMIC_RELAXED, __HIP_MEMORY_SCOPE_AGENT);
    {
        const int gt = (bx * 8 + wave) * 64 + lane;
        if (gt < 2048) {
            const int p = gt >> 4, f = gt & 15;
            const float inv = exp2f(-(float)f * (13.287712379549449f / 16.0f));
            const float ang = (float)p * inv;
            float rev = ang * 0.15915494309189535f; rev -= floorf(rev);
            ((f32x2*)(ws + WS_TAB))[gt] = (f32x2){__builtin_amdgcn_cosf(rev), __builtin_amdgcn_sinf(rev)};
        }
    }
}

__device__ __forceinline__ void phase1(LAS unsigned char* lds, int gw, int NGW, int lane, int wave) {
    unsigned char* ws = KWS;
    {
        LAS float* scr = (LAS float*)(lds + wave * 16640);
        const float* w_in = KIN(I_WIN); const float* w_out = KIN(I_WOUT);
        bf16_t* WT = (bf16_t*)(ws + WS_WT); bf16_t* WO = (bf16_t*)(ws + WS_WO);
        constexpr int NB_IN = INW / 64, NB_OUT = DM / 64, I_IN = 32 * NB_IN, I_OUT = 32 * NB_OUT;
        const int n_items = (NGW == 2048) ? I_IN : I_IN + I_OUT;
        for (int it = (NGW - 1 - gw); it < n_items; it += NGW) {
            if (it < I_IN) { const int kb = it / NB_IN, nb = it % NB_IN; transpose_item(w_in, INW, WT, kb * 64, nb * 64, true, scr, lane); }
            else { const int r2 = it - I_IN, kb = r2 / NB_OUT, nb = r2 % NB_OUT; transpose_item(w_out, DM, WO, kb * 64, nb * 64, false, scr, lane); }
        }
    }
    if (threadIdx.x == 0) {
        unsigned* cnt = (unsigned*)(ws + WS_P0CNT); const unsigned want = gridDim.x; unsigned spins = 0;
        while (__hip_atomic_load(cnt, __ATOMIC_RELAXED, __HIP_MEMORY_SCOPE_AGENT) < want) { __builtin_amdgcn_s_sleep(2); if (++spins > (1u << 20)) break; }
    }
    __syncthreads();
    const float* x = KIN(I_X); const float* ctx = KIN(I_CTX);
    {
        const float* b_ada = KIN(I_BADA); const float* norm_g = KIN(I_NORMG);
        float* modx = (float*)(ws + WS_MOD); float* modc = modx + 6144;
        const int col = threadIdx.x * 4;
        const f32x4 g = *(const f32x4*)(norm_g + col), bsh = *(const f32x4*)(b_ada + col), bsc = *(const f32x4*)(b_ada + 2048 + col);
        f32x4 sx, hx, sc, hc;
#pragma unroll
        for (int e = 0; e < 4; ++e) {
            sx[e] = __hip_atomic_load(modx + 2048 + col + e, __ATOMIC_RELAXED, __HIP_MEMORY_SCOPE_AGENT); hx[e] = __hip_atomic_load(modx + col + e, __ATOMIC_RELAXED, __HIP_MEMORY_SCOPE_AGENT);
            sc[e] = __hip_atomic_load(modc + 2048 + col + e, __ATOMIC_RELAXED, __HIP_MEMORY_SCOPE_AGENT); hc[e] = __hip_atomic_load(modc + col + e, __ATOMIC_RELAXED, __HIP_MEMORY_SCOPE_AGENT);
        }
        *(LAS f32x4*)(lds + 0 * 8192 + col * 4) = g * (1.0f + sx + bsc);
        *(LAS f32x4*)(lds + 1 * 8192 + col * 4) = hx + bsh;
        *(LAS f32x4*)(lds + 2 * 8192 + col * 4) = g * (1.0f + sc + bsc);
        *(LAS f32x4*)(lds + 3 * 8192 + col * 4) = hc + bsh;
    }
    __syncthreads();
    bf16_t* H = (bf16_t*)(ws + WS_H);
    f32x4 cur[8], nxt[8];
    int r = gw;
    if (r < NTOK) {
        const float* src = (r < CTXL) ? ctx + (size_t)r * DM : x + (size_t)(r - CTXL) * DM;
#pragma unroll
        for (int j = 0; j < 8; ++j) cur[j] = __builtin_nontemporal_load((const f32x4*)(src + (lane + 64 * j) * 4));
    }
    for (; r < NTOK; r += NGW) {
        const int rn = r + NGW;
        if (rn < NTOK) {
            const float* src = (rn < CTXL) ? ctx + (size_t)rn * DM : x + (size_t)(rn - CTXL) * DM;
#pragma unroll
            for (int j = 0; j < 8; ++j) nxt[j] = __builtin_nontemporal_load((const f32x4*)(src + (lane + 64 * j) * 4));
        }
        float ss = 0.f;
#pragma unroll
        for (int j = 0; j < 8; ++j) ss += (cur[j][0] * cur[j][0] + cur[j][1] * cur[j][1]) + (cur[j][2] * cur[j][2] + cur[j][3] * cur[j][3]);
        const float rstd = __builtin_amdgcn_rsqf(wave_sum(ss) * (1.0f / DM) + EPS);
        const int sel = (r < CTXL) ? 2 * 8192 : 0;
        bf16_t* dst = H + (size_t)r * DM;
#pragma unroll
        for (int j = 0; j < 8; ++j) {
            const int col = (lane + 64 * j) * 4;
            const f32x4 ge = *(const LAS f32x4*)(lds + sel + col * 4), sh = *(const LAS f32x4*)(lds + sel + 8192 + col * 4);
            const f32x4 o = cur[j] * rstd * ge + sh;
            u32x2 w; w.x = cvtpk(o[0], o[1]); w.y = cvtpk(o[2], o[3]);
            *(u32x2*)(dst + col) = w;
        }
#pragma unroll
        for (int j = 0; j < 8; ++j) cur[j] = nxt[j];
    }
    __syncthreads();
}

constexpr int AT_KBYTES = 16384, AT_VBYTES = 16384, AT_BUF = AT_KBYTES + AT_VBYTES;
constexpr int AT_XOFF = 0;
constexpr int AT_NT = NTOK / 64;
static_assert(3 * AT_BUF <= LDS_BYTES - 64, "attention ring");

__device__ __forceinline__ void attn_unit(unsigned char* ws, const float* sub_g, LAS unsigned char* lds, int h, int qb, float negM, float lam) {
    const int tid = threadIdx.x, lane = tid & 63, r32 = lane & 31, hi = lane >> 5;
    const int wid = __builtin_amdgcn_readfirstlane(tid >> 6), map = wid >> 2, wq = wid & 3;
    const int qrow0 = qb * 128 + 32 * wq;
    const bf16_t* Qp = (const bf16_t*)(ws + WS_Q); const bf16_t* Kp = (const bf16_t*)(ws + WS_K); const bf16_t* VTp = (const bf16_t*)(ws + WS_VT);
    bf16x8 qf[4];
    {
        const bf16_t* qp = Qp + (size_t)(qrow0 + r32) * 1024 + (h * 2 + map) * 64 + 8 * hi;
#pragma unroll
        for (int d0 = 0; d0 < 4; ++d0) qf[d0] = *(const bf16x8*)(qp + 16 * d0);
    }
    const bf16_t* kg[2]; const bf16_t* vg[2];
#pragma unroll
    for (int i = 0; i < 2; ++i) {
        const int g = 2 * wid + i;
        const int kr = 4 * g + (lane >> 4), kc = (lane & 15) ^ (kr & 15);
        kg[i] = Kp + (size_t)kr * 1024 + h * 128 + kc * 8;
        const int vr = 8 * g + (lane >> 3), vc = (lane & 7) ^ ((vr >> 1) & 7);
        vg[i] = VTp + (size_t)(h * 128 + vr) * NTOK + vc * 8;
    }
    const unsigned dmaoff = (unsigned)wid * 2048u;
#define AT_DMA(B) do { _Pragma("unroll") for (int i_ = 0; i_ < 2; ++i_) { \
        __builtin_amdgcn_global_load_lds((const unsigned*)kg[i_], (LAS unsigned*)(lds + (B) + dmaoff + i_ * 1024), 16, 0, 0); \
        __builtin_amdgcn_global_load_lds((const unsigned*)vg[i_], (LAS unsigned*)(lds + (B) + AT_KBYTES + dmaoff + i_ * 1024), 16, 0, 0); } } while (0)
#define AT_ADV() do { kg[0] += 64 * 1024; kg[1] += 64 * 1024; vg[0] += 64; vg[1] += 64; } while (0)
    int kad[4], vad[4];
#pragma unroll
    for (int d0 = 0; d0 < 4; ++d0) kad[d0] = r32 * 256 + (((map * 8 + 2 * d0 + hi) ^ (r32 & 15)) << 4);
#pragma unroll
    for (int j = 0; j < 4; ++j) vad[j] = AT_KBYTES + r32 * 128 + (((2 * j + hi) ^ ((r32 >> 1) & 7)) << 4);
#define SB() __builtin_amdgcn_sched_barrier(0)
#define KFR(B, d0, kh) (*(const LAS bf16x8*)(lds + (B) + kad[d0] + (kh) * 8192))
#define VFR(B, j, b) (*(const LAS bf16x8*)(lds + (B) + vad[j] + (b) * 4096))
    f32x16 o[4];
#pragma unroll
    for (int b = 0; b < 4; ++b)
#pragma unroll
        for (int r = 0; r < 16; ++r) o[b][r] = 0.f;
    f32x16 negm;
#pragma unroll
    for (int r = 0; r < 16; ++r) negm[r] = negM;
    float l0 = 0.f, l1 = 0.f;
    AT_DMA(0); AT_ADV();
    asm volatile("s_waitcnt vmcnt(0)" ::: "memory");
    __builtin_amdgcn_s_barrier();
    AT_DMA(AT_BUF); AT_ADV();
    f32x16 pa, pb;
    {
        f32x16 s0 = negm, s1 = negm;
#pragma unroll
        for (int d0 = 0; d0 < 4; ++d0) { s0 = __builtin_amdgcn_mfma_f32_32x32x16_bf16(KFR(0, d0, 0), qf[d0], s0, 0, 0, 0); s1 = __builtin_amdgcn_mfma_f32_32x32x16_bf16(KFR(0, d0, 1), qf[d0], s1, 0, 0, 0); }
#pragma unroll
        for (int r = 0; r < 16; ++r) { pa[r] = __builtin_amdgcn_exp2f(s0[r]); pb[r] = __builtin_amdgcn_exp2f(s1[r]); }
    }
    asm volatile("s_waitcnt vmcnt(0) lgkmcnt(0)" ::: "memory");
    __builtin_amdgcn_s_barrier();
    int bV = 0, bK = AT_BUF, bW = 2 * AT_BUF;
    u32x4 pw[4];
    for (int t = 1; t < AT_NT; ++t) {
        AT_DMA(bW);
        if (t + 2 < AT_NT) AT_ADV();
        SB();
#define FADDR(i) (((i) < 8) ? (bK + kad[(i) >> 1] + ((i) & 1) * 8192) : (bV + vad[((i) - 8) >> 2] + (((i) - 8) & 3) * 4096))
#define FLOAD(i) (*(const LAS bf16x8*)(lds + FADDR(i)))
#define ADD4(P, base) do { l0 = fadd_s(l0, P[base]); l1 = fadd_s(l1, P[base + 1]); l0 = fadd_s(l0, P[base + 2]); l1 = fadd_s(l1, P[base + 3]); } while (0)
#define EXP2(S, P, base) do { P[base] = __builtin_amdgcn_exp2f(S[base]); P[base + 1] = __builtin_amdgcn_exp2f(S[base + 1]); } while (0)
        f32x16 s0, s1;
        bf16x8 F0 = FLOAD(0), F1 = FLOAD(1), F2;
        SB();
        F2 = FLOAD(2); s0 = __builtin_amdgcn_mfma_f32_32x32x16_bf16(F0, qf[0], negm, 0, 0, 0); ADD4(pa, 0); pw[0][0] = cvtpk(pa[0], pa[1]); SB();
        F0 = FLOAD(3); s1 = __builtin_amdgcn_mfma_f32_32x32x16_bf16(F1, qf[0], negm, 0, 0, 0); ADD4(pa, 4); pw[0][1] = cvtpk(pa[2], pa[3]); SB();
        F1 = FLOAD(4); s0 = __builtin_amdgcn_mfma_f32_32x32x16_bf16(F2, qf[1], s0, 0, 0, 0); ADD4(pa, 8); pw[0][2] = cvtpk(pa[4], pa[5]); SB();
        F2 = FLOAD(5); s1 = __builtin_amdgcn_mfma_f32_32x32x16_bf16(F0, qf[1], s1, 0, 0, 0); ADD4(pa, 12); pw[0][3] = cvtpk(pa[6], pa[7]); SB();
        F0 = FLOAD(6); s0 = __builtin_amdgcn_mfma_f32_32x32x16_bf16(F1, qf[2], s0, 0, 0, 0); ADD4(pb, 0); pw[1][0] = cvtpk(pa[8], pa[9]); SB();
        F1 = FLOAD(7); s1 = __builtin_amdgcn_mfma_f32_32x32x16_bf16(F2, qf[2], s1, 0, 0, 0); ADD4(pb, 4); pw[1][1] = cvtpk(pa[10], pa[11]); SB();
        F2 = FLOAD(8); s0 = __builtin_amdgcn_mfma_f32_32x32x16_bf16(F0, qf[3], s0, 0, 0, 0); ADD4(pb, 8); pw[1][2] = cvtpk(pa[12], pa[13]); SB();
        F0 = FLOAD(9); s1 = __builtin_amdgcn_mfma_f32_32x32x16_bf16(F1, qf[3], s1, 0, 0, 0); ADD4(pb, 12); pw[1][3] = cvtpk(pa[14], pa[15]); SB();
        F1 = FLOAD(10); o[0] = __builtin_amdgcn_mfma_f32_32x32x16_bf16(F2, __builtin_bit_cast(bf16x8, pw[0]), o[0], 0, 0, 0); pw[2][0] = cvtpk(pb[0], pb[1]); EXP2(s0, pa, 0); SB();
        F2 = FLOAD(11); o[1] = __builtin_amdgcn_mfma_f32_32x32x16_bf16(F0, __builtin_bit_cast(bf16x8, pw[0]), o[1], 0, 0, 0); pw[2][1] = cvtpk(pb[2], pb[3]); EXP2(s0, pa, 2); SB();
        F0 = FLOAD(12); o[2] = __builtin_amdgcn_mfma_f32_32x32x16_bf16(F1, __builtin_bit_cast(bf16x8, pw[0]), o[2], 0, 0, 0); pw[2][2] = cvtpk(pb[4], pb[5]); EXP2(s0, pa, 4); SB();
        F1 = FLOAD(13); o[3] = __builtin_amdgcn_mfma_f32_32x32x16_bf16(F2, __builtin_bit_cast(bf16x8, pw[0]), o[3], 0, 0, 0); pw[2][3] = cvtpk(pb[6], pb[7]); EXP2(s0, pa, 6); SB();
        F2 = FLOAD(14); o[0] = __builtin_amdgcn_mfma_f32_32x32x16_bf16(F0, __builtin_bit_cast(bf16x8, pw[1]), o[0], 0, 0, 0); pw[3][0] = cvtpk(pb[8], pb[9]); EXP2(s0, pa, 8); SB();
        F0 = FLOAD(15); o[1] = __builtin_amdgcn_mfma_f32_32x32x16_bf16(F1, __builtin_bit_cast(bf16x8, pw[1]), o[1], 0, 0, 0); pw[3][1] = cvtpk(pb[10], pb[11]); EXP2(s0, pa, 10); SB();
        F1 = FLOAD(16); o[2] = __builtin_amdgcn_mfma_f32_32x32x16_bf16(F2, __builtin_bit_cast(bf16x8, pw[1]), o[2], 0, 0, 0); pw[3][2] = cvtpk(pb[12], pb[13]); EXP2(s0, pa, 12); SB();
        F2 = FLOAD(17); o[3] = __builtin_amdgcn_mfma_f32_32x32x16_bf16(F0, __builtin_bit_cast(bf16x8, pw[1]), o[3], 0, 0, 0); pw[3][3] = cvtpk(pb[14], pb[15]); EXP2(s0, pa, 14); SB();
        F0 = FLOAD(18); o[0] = __builtin_amdgcn_mfma_f32_32x32x16_bf16(F1, __builtin_bit_cast(bf16x8, pw[2]), o[0], 0, 0, 0); EXP2(s1, pb, 0); SB();
        F1 = FLOAD(19); o[1] = __builtin_amdgcn_mfma_f32_32x32x16_bf16(F2, __builtin_bit_cast(bf16x8, pw[2]), o[1], 0, 0, 0); EXP2(s1, pb, 2); SB();
        F2 = FLOAD(20); o[2] = __builtin_amdgcn_mfma_f32_32x32x16_bf16(F0, __builtin_bit_cast(bf16x8, pw[2]), o[2], 0, 0, 0); EXP2(s1, pb, 4); SB();
        F0 = FLOAD(21); o[3] = __builtin_amdgcn_mfma_f32_32x32x16_bf16(F1, __builtin_bit_cast(bf16x8, pw[2]), o[3], 0, 0, 0); EXP2(s1, pb, 6); SB();
        F1 = FLOAD(22); o[0] = __builtin_amdgcn_mfma_f32_32x32x16_bf16(F2, __builtin_bit_cast(bf16x8, pw[3]), o[0], 0, 0, 0); EXP2(s1, pb, 8); SB();
        F2 = FLOAD(23); o[1] = __builtin_amdgcn_mfma_f32_32x32x16_bf16(F0, __builtin_bit_cast(bf16x8, pw[3]), o[1], 0, 0, 0); EXP2(s1, pb, 10); SB();
        o[2] = __builtin_amdgcn_mfma_f32_32x32x16_bf16(F1, __builtin_bit_cast(bf16x8, pw[3]), o[2], 0, 0, 0); EXP2(s1, pb, 12); SB();
        o[3] = __builtin_amdgcn_mfma_f32_32x32x16_bf16(F2, __builtin_bit_cast(bf16x8, pw[3]), o[3], 0, 0, 0); EXP2(s1, pb, 14); SB();
#undef ADD4
#undef EXP2
#undef FADDR
#undef FLOAD
        asm volatile("s_waitcnt vmcnt(0) lgkmcnt(0)" ::: "memory");
        __builtin_amdgcn_s_barrier();
        const int tmp = bV; bV = bK; bK = bW; bW = tmp;
    }
    {
        float a0 = 0.f, a1 = 0.f;
#pragma unroll
        for (int r = 0; r < 16; ++r) { a0 += pa[r]; a1 += pb[r]; }
        l0 += a0; l1 += a1;
        pw[0] = (u32x4){cvtpk(pa[0], pa[1]), cvtpk(pa[2], pa[3]), cvtpk(pa[4], pa[5]), cvtpk(pa[6], pa[7])};
        pw[1] = (u32x4){cvtpk(pa[8], pa[9]), cvtpk(pa[10], pa[11]), cvtpk(pa[12], pa[13]), cvtpk(pa[14], pa[15])};
        pw[2] = (u32x4){cvtpk(pb[0], pb[1]), cvtpk(pb[2], pb[3]), cvtpk(pb[4], pb[5]), cvtpk(pb[6], pb[7])};
        pw[3] = (u32x4){cvtpk(pb[8], pb[9]), cvtpk(pb[10], pb[11]), cvtpk(pb[12], pb[13]), cvtpk(pb[14], pb[15])};
#pragma unroll
        for (int j = 0; j < 4; ++j)
#pragma unroll
            for (int b = 0; b < 4; ++b) o[b] = __builtin_amdgcn_mfma_f32_32x32x16_bf16(VFR(bV, j, b), __builtin_bit_cast(bf16x8, pw[j]), o[b], 0, 0, 0);
    }
    float l = l0 + l1;
#undef AT_DMA
#undef AT_ADV
#undef SB
#undef KFR
#undef VFR
    asm volatile("s_waitcnt vmcnt(0) lgkmcnt(0)" ::: "memory");
    __builtin_amdgcn_s_barrier();
    l += __shfl_xor(l, 32);
    const float inv = 1.0f / l;
    LAS float* xw = (LAS float*)(lds + AT_XOFF + wq * 16384);
    if (map == 1) {
        const float f = inv * lam;
#pragma unroll
        for (int b = 0; b < 4; ++b)
#pragma unroll
            for (int r = 0; r < 16; ++r) xw[(b * 16 + r) * 64 + lane] = o[b][r] * f;
    }
    __syncthreads();
    if (map == 0) {
        float ss = 0.f;
#pragma unroll
        for (int b = 0; b < 4; ++b)
#pragma unroll
            for (int r = 0; r < 16; ++r) { const float v = o[b][r] * inv - xw[(b * 16 + r) * 64 + lane]; o[b][r] = v; ss += v * v; }
        ss += __shfl_xor(ss, 32);
        const float rs = __builtin_amdgcn_rsqf(ss * (1.0f / VD) + EPS) * (1.0f - LAM_INIT);
        LAS unsigned char* stg = (LAS unsigned char*)xw;
#pragma unroll
        for (int b = 0; b < 4; ++b)
#pragma unroll
            for (int r4 = 0; r4 < 4; ++r4) {
                const int dv = 32 * b + 8 * r4 + 4 * hi;
                const f32x4 sg = *(const f32x4*)(sub_g + dv);
                u32x2 w; w.x = cvtpk(o[b][4 * r4 + 0] * rs * sg[0], o[b][4 * r4 + 1] * rs * sg[1]); w.y = cvtpk(o[b][4 * r4 + 2] * rs * sg[2], o[b][4 * r4 + 3] * rs * sg[3]);
                *(LAS u32x2*)(stg + r32 * 272 + dv * 2) = w;
            }
        asm volatile("s_waitcnt lgkmcnt(0)" ::: "memory");
        const bf16_t* GA = (const bf16_t*)(ws + WS_GA); bf16_t* MIX = (bf16_t*)(ws + WS_MIX);
        u32x4 gvs[8];
#pragma unroll
        for (int i = 0; i < 8; ++i) gvs[i] = *(const u32x4*)(GA + (size_t)(qrow0 + (lane >> 4) + 4 * i) * 1024 + h * 128 + (lane & 15) * 8);
#pragma unroll
        for (int i = 0; i < 8; ++i) {
            const int q = (lane >> 4) + 4 * i, ch = lane & 15;
            const u32x4 ov = *(const LAS u32x4*)(stg + q * 272 + ch * 16);
            const size_t tok = (size_t)(qrow0 + q);
            const u32x4 gv = gvs[i];
            u32x4 w;
            w.x = cvtpk(bf_lo(ov.x) * bf_lo(gv.x), bf_hi(ov.x) * bf_hi(gv.x)); w.y = cvtpk(bf_lo(ov.y) * bf_lo(gv.y), bf_hi(ov.y) * bf_hi(gv.y));
            w.z = cvtpk(bf_lo(ov.z) * bf_lo(gv.z), bf_hi(ov.z) * bf_hi(gv.z)); w.w = cvtpk(bf_lo(ov.w) * bf_lo(gv.w), bf_hi(ov.w) * bf_hi(gv.w));
            *(u32x4*)(MIX + tok * DM + h * 128 + ch * 8) = w;
        }
    }
    __syncthreads();
}

__device__ __forceinline__ void conv_unit(unsigned char* ws, LAS unsigned char* lds, int t0) {
    const int tid = threadIdx.x, lane = tid & 63, wid = tid >> 6, c0 = 2 * tid;
    const float* conv_w = KIN(I_CONVW); const float* conv_b = KIN(I_CONVB);
    const bf16_t* Y = (const bf16_t*)(ws + WS_Y);
    float y0[62], y1[62];
#pragma unroll
    for (int r = 0; r < 62; ++r) {
        const int row = t0 - 15 + r;
        unsigned yv = 0u;
        if (row >= 0 && row < SEQ) yv = *(const unsigned*)(Y + (size_t)row * CONVW + c0);
        y0[r] = bf_lo(yv); y1[r] = bf_hi(yv);
    }
    const f32x2 bias = *(const f32x2*)(conv_b + c0);
    float a0[32], a1[32];
#pragma unroll
    for (int t = 0; t < 32; ++t) { a0[t] = bias[0]; a1[t] = bias[1]; }
#pragma unroll
    for (int j = 0; j < CONVK; ++j) {
        const f32x2 w = *(const f32x2*)(conv_w + j * CONVW + c0);
#pragma unroll
        for (int t = 0; t < 32; ++t) { a0[t] += w[0] * y0[t + j]; a1[t] += w[1] * y1[t + j]; }
    }
    const bf16_t* GC = (const bf16_t*)(ws + WS_GC);
    unsigned gcv[32];
#pragma unroll
    for (int t = 0; t < 32; ++t) gcv[t] = *(const unsigned*)(GC + (size_t)(t0 + t) * CONVW + c0);
    float v[64];
#pragma unroll
    for (int t = 0; t < 32; ++t) { v[t] = a0[t] + a1[t]; v[32 + t] = a0[t] * a0[t] + a1[t] * a1[t]; }
#pragma unroll
    for (int h = 32; h >= 1; h >>= 1) {
        const bool up = (lane & h) != 0;
#pragma unroll
        for (int i = 0; i < h; ++i) {
            const float send = up ? v[i] : v[i + h], keep = up ? v[i + h] : v[i];
            v[i] = keep + __shfl_xor(send, h);
        }
    }
    LAS float* red = (LAS float*)lds;
    LAS float* stat = red + 512;
    red[wid * 64 + lane] = v[0];
    __syncthreads();
    if (tid < 32) {
        float s1 = 0.f, s2 = 0.f;
#pragma unroll
        for (int w = 0; w < 8; ++w) { s1 += red[w * 64 + tid]; s2 += red[w * 64 + 32 + tid]; }
        const float mean = s1 * (1.0f / CONVW), var = fmaxf(s2 * (1.0f / CONVW) - mean * mean, 0.f);
        stat[tid * 2] = mean; stat[tid * 2 + 1] = __builtin_amdgcn_rsqf(var + EPS);
    }
    __syncthreads();
    const float* ln_g = KIN(I_LNG); const float* ln_b = KIN(I_LNB);
    bf16_t* MIX = (bf16_t*)(ws + WS_MIX);
    const f32x2 lg = *(const f32x2*)(ln_g + c0), lb = *(const f32x2*)(ln_b + c0);
#pragma unroll
    for (int t = 0; t < 32; ++t) {
        const float mean = stat[t * 2], rstd = stat[t * 2 + 1];
        const float v0 = (a0[t] - mean) * rstd * lg[0] + lb[0], v1 = (a1[t] - mean) * rstd * lg[1] + lb[1];
        const unsigned gc = gcv[t];
        *(unsigned*)(MIX + (size_t)(t0 + t) * DM + ATTW + c0) = cvtpk(silu_f(v0) * bf_lo(gc), silu_f(v1) * bf_hi(gc));
    }
    __syncthreads();
}

#define XB_TMO      128
#define XB_XCNT(j)  (256  + 64 * (j))
#define XB_XSUB(j)  (1280 + 64 * (j))
#define XB_XGEN(j)  (2304 + 64 * (j))
#define XB_TOP      3328
#define XB_TOPGEN   3392
#define XCD_BAR_WORDS 3456
#define XB_SPIN_CAP (1u << 18)
__device__ __forceinline__ unsigned xb_ld(unsigned* p)              { return __hip_atomic_load(p, __ATOMIC_RELAXED, __HIP_MEMORY_SCOPE_AGENT); }
__device__ __forceinline__ unsigned xb_add(unsigned* p, unsigned v) { return __hip_atomic_fetch_add(p, v, __ATOMIC_RELAXED, __HIP_MEMORY_SCOPE_AGENT); }
__device__ __forceinline__ unsigned xb_xcc_id() { return (unsigned)__builtin_amdgcn_s_getreg((3 << 11) | 20) & 0xFu; }
#define XB_SPIN(cond, bar) do { unsigned _sp = 0; while (cond) { __builtin_amdgcn_s_sleep(1); \
    if ((++_sp & 255u) == 0u) { if (xb_ld(&(bar)[XB_TMO])) break; if (_sp > XB_SPIN_CAP) { atomicAdd(&(bar)[XB_TMO], 1u); break; } } } } while (0)
struct XcdBarrier { unsigned* bar; unsigned x; volatile LAS unsigned* st; };
__device__ __forceinline__ XcdBarrier xcd_barrier_post(unsigned* bar, volatile LAS unsigned* st) {
    XcdBarrier b; b.bar = bar; b.x = xb_xcc_id(); b.st = st;
    if (threadIdx.x == 0) st[3] = xb_add(&bar[XB_XCNT(b.x)], 1u);
    return b;
}
__device__ __forceinline__ void xcd_barrier_complete(unsigned* bar, unsigned x, unsigned& nloc, unsigned& nx, unsigned& uni) {
    const unsigned G = gridDim.x * gridDim.y * gridDim.z;
    unsigned sum, cnt, mine, sp = 0u, ok32;
    for (;;) {
        sum = 0u; cnt = 0u; mine = 0u; ok32 = 1u;
#pragma unroll
        for (unsigned j = 0; j < 16; ++j) { const unsigned c = xb_ld(&bar[XB_XCNT(j)]); sum += c; cnt += (c > 0u) ? 1u : 0u; mine = (j == x) ? c : mine; ok32 &= (c == ((j < 8u) ? 32u : 0u)) ? 1u : 0u; }
        if (sum == G) break;
        __builtin_amdgcn_s_sleep(1);
        if ((++sp & 255u) == 0u) { if (xb_ld(&bar[XB_TMO])) break; if (sp > XB_SPIN_CAP) { atomicAdd(&bar[XB_TMO], 1u); break; } }
    }
    nloc = mine > 0u ? mine : 1u; nx = cnt > 0u ? cnt : 1u; uni = (sum == G && G == 256u) ? ok32 : 0u;
}
__device__ __forceinline__ void xcd_barrier(const XcdBarrier& b) {
    asm volatile("s_waitcnt vmcnt(0)" ::: "memory");
    __syncthreads();
    if (threadIdx.x == 0) {
        unsigned* bar = b.bar;
        __builtin_amdgcn_s_waitcnt(0);
        unsigned nloc = b.st[0], nx = b.st[1];
        if (nloc == 0u) { unsigned uni; xcd_barrier_complete(bar, b.x, nloc, nx, uni); b.st[0] = nloc; b.st[1] = nx; b.st[2] = uni; }
        const unsigned old = xb_add(&bar[XB_XSUB(b.x)], 1u);
        const unsigned gen = old / nloc;
        if (old + 1u == (gen + 1u) * nloc) {
            __builtin_amdgcn_fence(__ATOMIC_RELEASE, "agent");
            asm volatile("s_waitcnt vmcnt(0)" ::: "memory");
            const unsigned og = xb_add(&bar[XB_TOP], 1u);
            const unsigned tg = og / nx;
            if (og + 1u == (tg + 1u) * nx) xb_add(&bar[XB_TOPGEN], 1u);
            else XB_SPIN(xb_ld(&bar[XB_TOPGEN]) == tg, bar);
            __builtin_amdgcn_fence(__ATOMIC_ACQUIRE, "agent");
            xb_add(&bar[XB_XGEN(b.x)], 1u);
            asm volatile("s_waitcnt vmcnt(0)" ::: "memory");
        } else {
            XB_SPIN(xb_ld(&bar[XB_XGEN(b.x)]) == gen, bar);
            __builtin_amdgcn_fence(__ATOMIC_ACQUIRE, "agent");
            asm volatile("s_waitcnt vmcnt(0)" ::: "memory");
        }
    }
    __syncthreads();
}

__global__ void __launch_bounds__(512, 2) fwd_kernel(Args args) {
    extern __shared__ __attribute__((aligned(16))) unsigned char lds_raw[];
    LAS unsigned char* lds = (LAS unsigned char*)lds_raw;
    cg::grid_group grid = cg::this_grid();
    const int tid = threadIdx.x, lane = tid & 63, wave = __builtin_amdgcn_readfirstlane(tid >> 6);
    const int G = gridDim.x, bx = blockIdx.x;
    const int gw = bx * 8 + wave, NGW = G * 8;
    const int lo = args.ph_lo, hi = args.ph_hi;
#define IN(k) (lo <= (k) && (k) < hi)
#define BOTH(k) (IN(k) && IN((k) + 1))
    volatile LAS unsigned* bst = (volatile LAS unsigned*)(lds + LDS_BYTES - 64);
    if (tid < 16) bst[tid] = 0u;
    __syncthreads();
    const XcdBarrier gbar = xcd_barrier_post((unsigned*)(KWS + WS_BAR), bst);
    if (lo > 1000) grid.sync();
#define GRID_SYNC() xcd_barrier(gbar)

    if (IN(0)) { phase0(lds, bx, G, lane, wave); __syncthreads(); }
    if (IN(1)) { phase1(lds, gw, NGW, lane, wave); if (BOTH(1)) GRID_SYNC(); }
    int vb = bx;
    if (BOTH(1) && bst[2] != 0u) vb = __builtin_amdgcn_readfirstlane((int)(bst[3] * 8u + gbar.x));
    const bool split2 = (G == 256) && (hi - lo == 5);
    if (IN(2)) {
        EpiIn E;
        if (split2) {
            { SchedIn S{(const char*)KWS, vb, G, 0, 768}; pg8::gemm_phase<EpiIn, SchedIn>(lds, S, E); }
            GRID_SYNC();
            if (vb < 136) { SchedIn S{(const char*)KWS, vb, G, 768, 904}; pg8::gemm_phase<EpiIn, SchedIn>(lds, S, E); }
            else {
                const int j = vb - 136;
                unsigned char* ws = KWS;
                for (int cu = j; cu < SEQ / 32; cu += 120) conv_unit(ws, lds, 32 * cu);
                if (j >= 16) {
                    LAS float* scr = (LAS float*)(lds + wave * 16640);
                    const float* w_out = KIN(I_WOUT); bf16_t* WO = (bf16_t*)(ws + WS_WO);
                    for (int it = (j - 16) * 8 + wave; it < 32 * (DM / 64); it += 104 * 8) { const int kb = it / (DM / 64), nb = it % (DM / 64); transpose_item(w_out, DM, WO, kb * 64, nb * 64, false, scr, lane); }
                }
            }
        } else {
            SchedIn S{(const char*)KWS, vb, G, 0, 904};
            pg8::gemm_phase<EpiIn, SchedIn>(lds, S, E);
            if (G == 256 && vb >= 136) {
                LAS float* scr = (LAS float*)(lds + wave * 16640);
                const float* w_out = KIN(I_WOUT); bf16_t* WO = (bf16_t*)(KWS + WS_WO);
                for (int it = (vb - 136) * 8 + wave; it < 32 * (DM / 64); it += 120 * 8) { const int kb = it / (DM / 64), nb = it % (DM / 64); transpose_item(w_out, DM, WO, kb * 64, nb * 64, false, scr, lane); }
            }
        }
        if (BOTH(2)) GRID_SYNC();
    }
    if (IN(3)) {
        const float* lq1 = KIN(I_LQ1); const float* lk1 = KIN(I_LK1); const float* lq2 = KIN(I_LQ2); const float* lk2 = KIN(I_LK2);
        const float d1 = wave_sum(lq1[lane] * lk1[lane]), d2 = wave_sum(lq2[lane] * lk2[lane]);
        const float lam = __expf(d1) - __expf(d2) + LAM_INIT;
        const float* qg = KIN(I_QG); const float* kg = KIN(I_KG);
        const float mq = wave_max(fabsf(qg[lane])), mk = wave_max(fabsf(kg[lane]));
        const float negM = -(QSCALE * 64.0f * mq * mk * 1.01f);
        unsigned char* ws = KWS;
        if (!split2) for (int t0 = vb * 32; t0 < SEQ; t0 += G * 32) conv_unit(ws, lds, t0);
        const float* sub_g = KIN(I_SUBG);
        for (int u = vb; u < NH * (SEQ / 128); u += G) attn_unit(ws, sub_g, lds, u & 7, u >> 3, negM, lam);
        if (BOTH(3)) GRID_SYNC();
    }
    if (IN(4)) {
        SchedOut S{(const char*)KWS, vb, G};
        EpiOut E;
        pg8::gemm_phase<EpiOut, SchedOut>(lds, S, E);
    }
#undef IN
#undef BOTH
}

extern "C" void kernel_launch(void* const* d_in, const int* in_sizes, int n_in, void* d_out, int out_size, void* d_ws, size_t ws_size, hipStream_t stream) {
    static int grid = 0;
    if (grid == 0) {
        if (n_in != 20 || out_size != SEQ * DM || ws_size < WS_END) { fprintf(stderr, "kernel_launch: unexpected shapes (n_in %d out %d ws %zu)\n", n_in, out_size, ws_size); grid = -1; return; }
        int dev = 0, cus = 0, per_cu = 0;
        if (hipGetDevice(&dev) != hipSuccess || hipDeviceGetAttribute(&cus, hipDeviceAttributeMultiprocessorCount, dev) != hipSuccess) { grid = -1; return; }
        if (hipFuncSetAttribute((const void*)fwd_kernel, hipFuncAttributeMaxDynamicSharedMemorySize, LDS_BYTES) != hipSuccess) { fprintf(stderr, "kernel_launch: hipFuncSetAttribute failed\n"); grid = -1; return; }
        if (hipOccupancyMaxActiveBlocksPerMultiprocessor(&per_cu, (const void*)fwd_kernel, 512, LDS_BYTES) != hipSuccess || per_cu < 1) { fprintf(stderr, "kernel_launch: occupancy query gave %d\n", per_cu); per_cu = 1; }
        (void)hipGetLastError();
        grid = cus * 1;
    }
    if (grid < 0) return;
    (void)hipMemsetAsync((char*)d_ws + WS_MOD, 0, WS_ZERO_BYTES, stream);
    Args a{};
    for (int i = 0; i < 20; ++i) a.in[i] = (const float*)d_in[i];
    a.out = (float*)d_out; a.ws = (unsigned char*)d_ws;
#if MK_N_LAUNCHES == 1
    a.ph_lo = 0; a.ph_hi = 5;
    void* kargs[] = {&a};
    hipError_t e = hipLaunchCooperativeKernel((const void*)fwd_kernel, dim3(grid), dim3(512), kargs, LDS_BYTES, stream);
    if (e != hipSuccess) {
        fprintf(stderr, "cooperative launch failed: %s (grid %d); falling back to one launch per phase\n", hipGetErrorString(e), grid);
        (void)hipGetLastError();
        for (int ph = 0; ph < 5; ++ph) { a.ph_lo = ph; a.ph_hi = ph + 1; hipLaunchKernelGGL(fwd_kernel, dim3(grid), dim3(512), LDS_BYTES, stream, a); }
    }
#else
    for (int ph = 0; ph < 5; ++ph) {
        a.ph_lo = ph; a.ph_hi = ph + 1;
        hipLaunchKernelGGL(fwd_kernel, dim3(grid), dim3(512), LDS_BYTES, stream, a);
    }
#endif
}
```
